# Optimizing an MI355X kernel written in HIP

```python
import jax, jax.numpy as jnp
from jax import lax
import numpy as np

D_MODEL = 1024
BATCH = 32
SEQ = 256
DEPTH = 1
DEC_BATCH = 4
DEC_SEQ = 4096
PAST_LEN = 512

GRID_W = 64
D_MIX = 1024
HEAD_DIM = 64
N_ATTN_HEADS = 8
N_KV_HEADS = 2
KV_GROUP = N_ATTN_HEADS // N_KV_HEADS
ATTN_WIDTH = N_ATTN_HEADS * HEAD_DIM
KV_WIDTH = N_KV_HEADS * HEAD_DIM
WINDOW = 128
BLOCK = 128
N_GLA_HEADS = 4
GLA_DK = 64
GLA_DV = 128
GLA_K_WIDTH = N_GLA_HEADS * GLA_DK
GLA_V_WIDTH = N_GLA_HEADS * GLA_DV
GATE_RANK = 16
GATE_NORMALIZER = 16.0
CHUNK = 64
ROPE_BASE = 10000.0
EPS = 1e-6
NEG_INF = -1e30
PROJ_SIZES = (ATTN_WIDTH, KV_WIDTH, KV_WIDTH, ATTN_WIDTH, GLA_K_WIDTH, GLA_K_WIDTH, GLA_V_WIDTH, GATE_RANK, GATE_RANK, GLA_V_WIDTH)
D_IN = 2848

kernel_name = "hymba_window_gqa_gla_prefix_dit_step"


def rmsnorm(x, g):
    xf = x.astype(jnp.float32)
    xf = xf * lax.rsqrt(jnp.mean(xf * xf, axis=-1, keepdims=True) + EPS)
    return xf.astype(x.dtype) * g


def adaln(cvec, w_mod, b_mod):
    m = jax.nn.silu(cvec) @ w_mod + b_mod
    shift, scale, gate = jnp.split(m, 3, axis=-1)
    return shift[:, None, :], scale[:, None, :], gate[:, None, :]


def axial_rope(x):
    n_tok = x.shape[1]
    rows = n_tok // GRID_W
    r = jnp.repeat(jnp.arange(rows, dtype=jnp.float32), GRID_W)
    col = jnp.tile(jnp.arange(GRID_W, dtype=jnp.float32), rows)
    half = HEAD_DIM // 2
    nf = half // 2
    freqs = ROPE_BASE ** (-jnp.arange(nf, dtype=jnp.float32) / nf)

    def rot(xs, pos):
        ang = pos[:, None] * freqs[None, :]
        cos = jnp.cos(ang)[:, None, :]
        sin = jnp.sin(ang)[:, None, :]
        x1, x2 = xs[..., :nf], xs[..., nf:]
        return jnp.concatenate([x1 * cos - x2 * sin, x2 * cos + x1 * sin], axis=-1)

    xf = x.astype(jnp.float32)
    out = jnp.concatenate([rot(xf[..., :half], r), rot(xf[..., half:], col)], axis=-1)
    return out.astype(x.dtype)


def sink_softmax_attend(q, parts, sink):
    bsz, nq = q.shape[0], q.shape[1]
    scale = HEAD_DIM ** -0.5
    logits = []
    for k, v, mask in parts:
        s = jnp.einsum('bqkgd,bskd->bkgqs', q, k).astype(jnp.float32) * scale
        if mask is not None:
            s = jnp.where(mask, s, NEG_INF)
        logits.append(s)
    sink_l = jnp.broadcast_to(sink.astype(jnp.float32).reshape(1, N_KV_HEADS, KV_GROUP, 1, 1), (bsz, N_KV_HEADS, KV_GROUP, nq, 1))
    p = jax.nn.softmax(jnp.concatenate(logits + [sink_l], axis=-1), axis=-1)
    outs = []
    off = 0
    for k, v, _ in parts:
        n_k = k.shape[1]
        outs.append(jnp.einsum('bkgqs,bskd->bqkgd', p[..., off:off + n_k].astype(v.dtype), v))
        off += n_k
    return sum(outs).reshape(bsz, nq, ATTN_WIDTH)


def context_attention(q, k, v, sink):
    bsz, n_tok = q.shape[0], q.shape[1]
    nb = n_tok // BLOCK
    qb = q.reshape(bsz, nb, BLOCK, N_KV_HEADS, KV_GROUP, HEAD_DIM).transpose(1, 0, 2, 3, 4, 5)
    out = lax.map(lambda qi: sink_softmax_attend(qi, [(k, v, None)], sink), qb)
    return out.transpose(1, 0, 2, 3).reshape(bsz, n_tok, ATTN_WIDTH)


def latent_attention(q, k, v, k_ctx, v_ctx, sink):
    bsz, n_tok = q.shape[0], q.shape[1]
    nb = n_tok // BLOCK
    qb = q.reshape(bsz, nb, BLOCK, N_KV_HEADS, KV_GROUP, HEAD_DIM).transpose(1, 0, 2, 3, 4, 5)
    pad = ((0, 0), (BLOCK, BLOCK), (0, 0), (0, 0))
    kp = jnp.pad(k, pad).reshape(bsz, nb + 2, BLOCK, N_KV_HEADS, HEAD_DIM)
    vp = jnp.pad(v, pad).reshape(bsz, nb + 2, BLOCK, N_KV_HEADS, HEAD_DIM)

    def window(t):
        return jnp.concatenate([t[:, 0:nb], t[:, 1:nb + 1], t[:, 2:nb + 2]], axis=2).transpose(1, 0, 2, 3, 4)

    blk = jnp.arange(nb)[:, None] * BLOCK
    qpos = blk + jnp.arange(BLOCK)[None, :]
    kpos = blk - BLOCK + jnp.arange(3 * BLOCK)[None, :]
    mask = (jnp.abs(qpos[:, :, None] - kpos[:, None, :]) <= WINDOW) & ((kpos >= 0) & (kpos < n_tok))[:, None, :]

    def block(args):
        qi, ki, vi, mi = args
        return sink_softmax_attend(qi, [(ki, vi, mi), (k_ctx, v_ctx, None)], sink)

    out = lax.map(block, (qb, window(kp), window(vp), mask))
    return out.transpose(1, 0, 2, 3).reshape(bsz, n_tok, ATTN_WIDTH)


def gla_scan(q, k, v, g, s0):
    bsz, n_tok = q.shape[0], q.shape[1]
    n = n_tok // CHUNK

    def rs(t):
        return t.reshape(bsz, n, CHUNK, t.shape[2], t.shape[3]).astype(jnp.float32)

    qf, kf, vf, gf = rs(q), rs(k), rs(v), rs(g)
    gc = jnp.cumsum(gf, axis=2)
    gtot = gc[:, :, -1]
    q_dec = qf * jnp.exp(gc) * (GLA_DK ** -0.5)
    k_inv = kf * jnp.exp(-gc)
    k_end = kf * jnp.exp(gtot[:, :, None] - gc)
    causal = jnp.tril(jnp.ones((CHUNK, CHUNK), dtype=bool))
    a = jnp.where(causal, jnp.einsum('bnihd,bnjhd->bnhij', q_dec, k_inv), 0.0)
    o_intra = jnp.einsum('bnhij,bnjhv->bnihv', a, vf)
    ds = jnp.einsum('bnjhd,bnjhv->bnhdv', k_end, vf)

    def step(s, xs):
        decay, d = xs
        return jnp.exp(decay)[..., None] * s + d, s

    s_fin, s_prev = lax.scan(step, s0.astype(jnp.float32), (gtot.transpose(1, 0, 2, 3), ds.transpose(1, 0, 2, 3, 4)))
    o_inter = jnp.einsum('bnihd,nbhdv->bnihv', q_dec, s_prev)
    o = (o_inter + o_intra).reshape(bsz, n_tok, N_GLA_HEADS, GLA_DV)
    return o.astype(v.dtype), s_fin.astype(v.dtype)


def gla_bidir(q, k, v, g_f, g_b, s0_f, s0_b):
    o_f, s_f = gla_scan(q, k, v, g_f, s0_f)
    o_b, s_b = gla_scan(q[:, ::-1], k[:, ::-1], v[:, ::-1], g_b[:, ::-1], s0_b)
    return o_f + o_b[:, ::-1], s_f, s_b


def project(x, shift, scale, norm_g, w_in, w_gk_f, b_gk_f, w_gk_b, b_gk_b):
    bsz, n_tok, _ = x.shape
    h = rmsnorm(x, norm_g) * (1 + scale) + shift
    z = h @ w_in
    q, k, v, za, qg, kg, vg, lr_f, lr_b, zg = jnp.split(z, list(np.cumsum(PROJ_SIZES)[:-1]), axis=-1)
    q = q.reshape(bsz, n_tok, N_ATTN_HEADS, HEAD_DIM)
    k = k.reshape(bsz, n_tok, N_KV_HEADS, HEAD_DIM)
    v = v.reshape(bsz, n_tok, N_KV_HEADS, HEAD_DIM)
    qg = qg.reshape(bsz, n_tok, N_GLA_HEADS, GLA_DK)
    kg = kg.reshape(bsz, n_tok, N_GLA_HEADS, GLA_DK)
    vg = vg.reshape(bsz, n_tok, N_GLA_HEADS, GLA_DV)
    g_f = (jax.nn.log_sigmoid((lr_f @ w_gk_f + b_gk_f).astype(jnp.float32)) / GATE_NORMALIZER).reshape(bsz, n_tok, N_GLA_HEADS, GLA_DK)
    g_b = (jax.nn.log_sigmoid((lr_b @ w_gk_b + b_gk_b).astype(jnp.float32)) / GATE_NORMALIZER).reshape(bsz, n_tok, N_GLA_HEADS, GLA_DK)
    return q, k, v, za, qg, kg, vg, g_f, g_b, zg


def merge(o_a, za, o_g, zg, gla_norm_g, w_out):
    bsz, n_tok = o_a.shape[0], o_a.shape[1]
    ya = o_a * jax.nn.silu(za)
    yg = (rmsnorm(o_g, gla_norm_g).reshape(bsz, n_tok, GLA_V_WIDTH)) * jax.nn.silu(zg)
    return jnp.concatenate([ya, yg], axis=-1) @ w_out


def setup_inputs(seed: int = 0) -> dict:
    key = jax.random.key(seed)
    ks = jax.random.split(key, 20)
    f32 = jnp.float32
    nrm = lambda k, shape, s: jax.random.normal(k, shape, f32) * s
    return {
        "x_prompt": nrm(ks[0], (BATCH, SEQ, D_MODEL), 1.0),
        "x_sample": nrm(ks[1], (DEC_BATCH, DEC_SEQ, D_MODEL), 1.0),
        "c": nrm(ks[2], (DEC_BATCH, D_MODEL), 1.0),
        "cache_k": nrm(ks[3], (DEC_BATCH, DEPTH, PAST_LEN, N_KV_HEADS, HEAD_DIM), 1.0),
        "cache_v": nrm(ks[4], (DEC_BATCH, DEPTH, PAST_LEN, N_KV_HEADS, HEAD_DIM), 1.0),
        "state_gla": nrm(ks[5], (DEC_BATCH, DEPTH, 2, N_GLA_HEADS, GLA_DK, GLA_DV), 0.5),
        "c_ctx": nrm(ks[6], (D_MODEL,), 1.0),
        "w_mod": nrm(ks[7], (DEPTH, D_MODEL, 3 * D_MODEL), 0.5 * D_MODEL ** -0.5),
        "b_mod": nrm(ks[8], (DEPTH, 3 * D_MODEL), 0.02),
        "norm_g": 1.0 + nrm(ks[9], (DEPTH, D_MODEL), 0.02),
        "w_in": nrm(ks[10], (DEPTH, D_MODEL, D_IN), D_MODEL ** -0.5),
        "w_gk_f": nrm(ks[11], (DEPTH, GATE_RANK, GLA_K_WIDTH), GATE_RANK ** -0.5),
        "b_gk_f": nrm(ks[12], (DEPTH, GLA_K_WIDTH), 0.1),
        "w_gk_b": nrm(ks[13], (DEPTH, GATE_RANK, GLA_K_WIDTH), GATE_RANK ** -0.5),
        "b_gk_b": nrm(ks[14], (DEPTH, GLA_K_WIDTH), 0.1),
        "sink": nrm(ks[15], (DEPTH, N_ATTN_HEADS), 0.5),
        "gla_norm_g": 1.0 + nrm(ks[16], (DEPTH, GLA_DV), 0.02),
        "w_out": nrm(ks[17], (DEPTH, D_MIX, D_MODEL), D_MIX ** -0.5),
        "final_norm_g": 1.0 + nrm(ks[18], (D_MODEL,), 0.02),
    }


def reference(x_prompt, x_sample, c, cache_k, cache_v, state_gla, c_ctx, w_mod, b_mod, norm_g, w_in,
              w_gk_f, b_gk_f, w_gk_b, b_gk_b, sink, gla_norm_g, w_out, final_norm_g):
    xp = x_prompt
    xs = x_sample
    bp = xp.shape[0]
    new_k_list, new_v_list, new_s_list = [], [], []
    for l in range(DEPTH):
        shift, scale, gate = adaln(c_ctx[None, :], w_mod[l], b_mod[l])
        q, k, v, za, qg, kg, vg, g_f, g_b, zg = project(xp, shift, scale, norm_g[l], w_in[l], w_gk_f[l], b_gk_f[l], w_gk_b[l], b_gk_b[l])
        o_a = context_attention(q, k, v, sink[l])
        s_zero = jnp.zeros((bp, N_GLA_HEADS, GLA_DK, GLA_DV), xp.dtype)
        o_g, s_f, s_b = gla_bidir(qg, kg, vg, g_f, g_b, s_zero, s_zero)
        xp = xp + gate * merge(o_a, za, o_g, zg, gla_norm_g[l], w_out[l])
        new_k_list.append(k)
        new_v_list.append(v)
        new_s_list.append(jnp.stack([s_f, s_b], axis=1))

        shift, scale, gate = adaln(c, w_mod[l], b_mod[l])
        q, k, v, za, qg, kg, vg, g_f, g_b, zg = project(xs, shift, scale, norm_g[l], w_in[l], w_gk_f[l], b_gk_f[l], w_gk_b[l], b_gk_b[l])
        q = axial_rope(q)
        k = axial_rope(k)
        o_a = latent_attention(q, k, v, cache_k[:, l], cache_v[:, l], sink[l])
        o_g, _, _ = gla_bidir(qg, kg, vg, g_f, g_b, state_gla[:, l, 0], state_gla[:, l, 1])
        xs = xs + gate * merge(o_a, za, o_g, zg, gla_norm_g[l], w_out[l])

    y_prompt = rmsnorm(xp, final_norm_g)
    y_sample = rmsnorm(xs, final_norm_g)
    new_k = jnp.stack(new_k_list, axis=1)
    new_v = jnp.stack(new_v_list, axis=1)
    new_state = jnp.stack(new_s_list, axis=1)
    return (y_prompt, y_sample, new_k, new_v, new_state)
```

```cpp
#include <hip/hip_runtime.h>
#include <hip/hip_cooperative_groups.h>
#include <cstdio>
namespace cg = cooperative_groups;

typedef unsigned short u16;
using bf16x8 = __attribute__((ext_vector_type(8))) short;
using f32x4  = __attribute__((ext_vector_type(4))) float;
using f32x16 = __attribute__((ext_vector_type(16))) float;
using u32x4 = __attribute__((ext_vector_type(4))) unsigned;

#define T_TOK   24576
#define NP_TOK  8192
#define DM      1024
#define ZW      2848
#define ZWP     2944
#define EPSV    1e-6f

#define C_Q   0
#define C_K   512
#define C_V   640
#define C_ZA  768
#define C_QG  1280
#define C_KG  1536
#define C_VG  1792
#define C_LR  2304
#define C_ZG  2336

#define OFF_MOD   0ull
#define OFF_ROPE  65536ull
#define OFF_DEC   131072ull
#define OFF_LR    1048576ull
#define OFF_WINT  4194304ull
#define OFF_WOUTT 10223616ull
#define OFF_HY    12582912ull
#define OFF_Z     62914560ull
#define OFF_SPT   202899456ull

#define OUT_Y     0
#define OUT_NK    25165824
#define OUT_NV    26214400
#define OUT_NS    27262976

#define LDS_BYTES 59392

struct Params {
  const float *xp, *xs, *c, *cache_k, *cache_v, *state_gla, *c_ctx, *w_mod, *b_mod, *norm_g, *w_in,
              *w_gk_f, *b_gk_f, *w_gk_b, *b_gk_b, *sink, *gla_norm_g, *w_out, *final_norm_g;
  float* out;
  unsigned char* ws;
};

__device__ __forceinline__ u16 f2bf(float f) {
  unsigned u = __float_as_uint(f);
  u += 0x7fffu + ((u >> 16) & 1u);
  return (u16)(u >> 16);
}
__device__ __forceinline__ float bf2f(u16 h) { return __uint_as_float(((unsigned)h) << 16); }
__device__ __forceinline__ unsigned pack2(float a, float b) { return (unsigned)f2bf(a) | ((unsigned)f2bf(b) << 16); }
__device__ __forceinline__ float bflo(unsigned u) { return __uint_as_float(u << 16); }
__device__ __forceinline__ float bfhi(unsigned u) { return __uint_as_float(u & 0xffff0000u); }
__device__ __forceinline__ float siluf(float x) { return x / (1.f + __expf(-x)); }
__device__ __forceinline__ float logsigf(float x) { return fminf(x, 0.f) - __logf(1.f + __expf(-fabsf(x))); }
__device__ __forceinline__ int rowmap(int reg, int hh) { return (reg & 3) + 8 * (reg >> 2) + 4 * hh; }

__device__ __forceinline__ f32x16 mfma32(bf16x8 a, bf16x8 b, f32x16 c) {
  return __builtin_amdgcn_mfma_f32_32x32x16_bf16(a, b, c, 0, 0, 0);
}
__device__ __forceinline__ f32x4 mfma16(bf16x8 a, bf16x8 b, f32x4 c) {
  return __builtin_amdgcn_mfma_f32_16x16x32_bf16(a, b, c, 0, 0, 0);
}
__device__ __forceinline__ const float* xrow_ptr(const Params& p, int t) {
  return (t < NP_TOK) ? (p.xp + (size_t)t * DM) : (p.xs + (size_t)(t - NP_TOK) * DM);
}
__device__ __forceinline__ int mod_idx(int t) { return (t < NP_TOK) ? 0 : 1 + ((t - NP_TOK) >> 12); }

__device__ const double kFreq[16] = {
  1.0, 0.5623413251903491, 0.31622776601683794, 0.1778279410038923, 0.1, 0.05623413251903491,
  0.03162277660168379, 0.01778279410038923, 0.01, 0.005623413251903491, 0.0031622776601683794,
  0.0017782794100389228, 0.001, 0.0005623413251903491, 0.00031622776601683794, 0.00017782794100389227};

__device__ void p0_adaln(const Params& p, int task, unsigned char* smem) {
  float* sc  = (float*)smem;
  float* red = sc + 5120;
  float* MOD = (float*)(p.ws + OFF_MOD);
  const int tid = threadIdx.x;
  for (int e = tid; e < 5120; e += 256) {
    int i = e >> 10, k = e & 1023;
    float v = (i == 0) ? p.c_ctx[k] : p.c[(i - 1) * 1024 + k];
    sc[e] = siluf(v);
  }
  __syncthreads();
  const int rg = tid >> 2, qd = tid & 3;
  const int c0 = task * 16 + qd * 4;
  float acc[5][4];
#pragma unroll
  for (int i = 0; i < 5; ++i)
#pragma unroll
    for (int j = 0; j < 4; ++j) acc[i][j] = 0.f;
#pragma unroll 4
  for (int it = 0; it < 16; ++it) {
    int row = it * 64 + rg;
    float4 w = *(const float4*)(p.w_mod + (size_t)row * 3072 + c0);
#pragma unroll
    for (int i = 0; i < 5; ++i) {
      float s = sc[i * 1024 + row];
      acc[i][0] += s * w.x; acc[i][1] += s * w.y; acc[i][2] += s * w.z; acc[i][3] += s * w.w;
    }
  }
#pragma unroll
  for (int i = 0; i < 5; ++i)
#pragma unroll
    for (int j = 0; j < 4; ++j) red[rg * 80 + i * 16 + qd * 4 + j] = acc[i][j];
  __syncthreads();
  if (tid < 80) {
    int i = tid >> 4, cc = tid & 15;
    float s = 0.f;
    for (int r = 0; r < 64; ++r) s += red[r * 80 + tid];
    MOD[i * 3072 + task * 16 + cc] = s + p.b_mod[task * 16 + cc];
  }
  __syncthreads();
}

__device__ void p0_transpose(const float* W, int N, u16* WT, int kt, int nt, unsigned char* smem) {
  float* tile = (float*)smem;
  const int tid = threadIdx.x;
  const int r = tid >> 4, c4 = (tid & 15) * 4;
  const int k0 = kt * 64, n0 = nt * 64;
#pragma unroll
  for (int it = 0; it < 4; ++it) {
    int row = r + 16 * it;
    float4 v = make_float4(0.f, 0.f, 0.f, 0.f);
    if (n0 + c4 < N) v = *(const float4*)(W + (size_t)(k0 + row) * N + n0 + c4);
    tile[row * 65 + c4 + 0] = v.x; tile[row * 65 + c4 + 1] = v.y;
    tile[row * 65 + c4 + 2] = v.z; tile[row * 65 + c4 + 3] = v.w;
  }
  __syncthreads();
  const int n = tid >> 2, kq = (tid & 3) * 16;
  unsigned u[8];
#pragma unroll
  for (int j = 0; j < 8; ++j) u[j] = pack2(tile[(kq + 2 * j) * 65 + n], tile[(kq + 2 * j + 1) * 65 + n]);
  uint4* dst = (uint4*)(WT + (size_t)(n0 + n) * 1024 + k0 + kq);
  dst[0] = make_uint4(u[0], u[1], u[2], u[3]);
  dst[1] = make_uint4(u[4], u[5], u[6], u[7]);
  __syncthreads();
}

__device__ void p0_rope(const Params& p) {
  float* ROPE = (float*)(p.ws + OFF_ROPE);
  const int tid = threadIdx.x;
  if (tid < 16) {
    double f = kFreq[tid];
    double x2 = f * f, s = 1.0, c = 1.0;
    for (int n = 10; n >= 1; --n) {
      s = 1.0 - x2 / (double)((2 * n) * (2 * n + 1)) * s;
      c = 1.0 - x2 / (double)((2 * n - 1) * (2 * n)) * c;
    }
    s *= f;
    double cc = 1.0, ss = 0.0;
    for (int pos = 0; pos < 64; ++pos) {
      ROPE[pos * 16 + tid] = (float)cc;
      ROPE[1024 + pos * 16 + tid] = (float)ss;
      double nc = cc * c - ss * s, ns = ss * c + cc * s;
      cc = nc; ss = ns;
    }
  }
}

__device__ void p1_rows(const Params& p) {
  const float* MOD = (const float*)(p.ws + OFF_MOD);
  u16* H = (u16*)(p.ws + OFF_HY);
  const int lane = threadIdx.x & 63, w = threadIdx.x >> 6;
  for (int row = blockIdx.x * 4 + w; row < T_TOK; row += gridDim.x * 4) {
    const float* x = xrow_ptr(p, row);
    const float* md = MOD + mod_idx(row) * 3072;
    float4 v[4];
    float ss = 0.f;
#pragma unroll
    for (int i = 0; i < 4; ++i) {
      v[i] = *(const float4*)(x + i * 256 + lane * 4);
      ss += v[i].x * v[i].x + v[i].y * v[i].y + v[i].z * v[i].z + v[i].w * v[i].w;
    }
#pragma unroll
    for (int o = 32; o >= 1; o >>= 1) ss += __shfl_xor(ss, o);
    const float rstd = rsqrtf(ss * (1.f / 1024.f) + EPSV);
#pragma unroll
    for (int i = 0; i < 4; ++i) {
      int col = i * 256 + lane * 4;
      float4 g = *(const float4*)(p.norm_g + col);
      float4 sh = *(const float4*)(md + col);
      float4 sc = *(const float4*)(md + 1024 + col);
      float h0 = v[i].x * rstd * g.x * (1.f + sc.x) + sh.x;
      float h1 = v[i].y * rstd * g.y * (1.f + sc.y) + sh.y;
      float h2 = v[i].z * rstd * g.z * (1.f + sc.z) + sh.z;
      float h3 = v[i].w * rstd * g.w * (1.f + sc.w) + sh.w;
      uint2 o2 = make_uint2(pack2(h0, h1), pack2(h2, h3));
      *(uint2*)(H + (size_t)row * DM + col) = o2;
    }
  }
}

template <int MODE>
__device__ void gemm_tile(const Params& p, const u16* __restrict__ A, const u16* __restrict__ Bt, int mt, int nt,
                          unsigned char* smem) {
  u16* As = (u16*)smem;
  u16* Bs = As + 128 * 72;
  const int tid = threadIdx.x, lane = tid & 63, wid = tid >> 6;
  const int wr = wid >> 1, wc = wid & 1, fr = lane & 15, fq = lane >> 4;
  f32x4 acc[4][4];
#pragma unroll
  for (int m = 0; m < 4; ++m)
#pragma unroll
    for (int n = 0; n < 4; ++n) acc[m][n] = (f32x4){0.f, 0.f, 0.f, 0.f};
  const int lrw = tid >> 3, lc = (tid & 7) * 8;
  const u16* Ap = A + (size_t)(mt * 128 + lrw) * 1024 + lc;
  const u16* Bp = Bt + (size_t)(nt * 128 + lrw) * 1024 + lc;
  uint4 ra0, ra1, ra2, ra3, rb0, rb1, rb2, rb3;
#define GLOADAB(koff)                                              \
  ra0 = *(const uint4*)(Ap + (size_t)0 * 32 * 1024 + (koff));      \
  ra1 = *(const uint4*)(Ap + (size_t)1 * 32 * 1024 + (koff));      \
  ra2 = *(const uint4*)(Ap + (size_t)2 * 32 * 1024 + (koff));      \
  ra3 = *(const uint4*)(Ap + (size_t)3 * 32 * 1024 + (koff));      \
  rb0 = *(const uint4*)(Bp + (size_t)0 * 32 * 1024 + (koff));      \
  rb1 = *(const uint4*)(Bp + (size_t)1 * 32 * 1024 + (koff));      \
  rb2 = *(const uint4*)(Bp + (size_t)2 * 32 * 1024 + (koff));      \
  rb3 = *(const uint4*)(Bp + (size_t)3 * 32 * 1024 + (koff));
  GLOADAB(0)
  for (int kt = 0; kt < 16; ++kt) {
    __syncthreads();
    *(uint4*)&As[(lrw + 0) * 72 + lc] = ra0;
    *(uint4*)&As[(lrw + 32) * 72 + lc] = ra1;
    *(uint4*)&As[(lrw + 64) * 72 + lc] = ra2;
    *(uint4*)&As[(lrw + 96) * 72 + lc] = ra3;
    *(uint4*)&Bs[(lrw + 0) * 72 + lc] = rb0;
    *(uint4*)&Bs[(lrw + 32) * 72 + lc] = rb1;
    *(uint4*)&Bs[(lrw + 64) * 72 + lc] = rb2;
    *(uint4*)&Bs[(lrw + 96) * 72 + lc] = rb3;
    __syncthreads();
    {
      const int kn = (kt + 1 < 16) ? (kt + 1) : kt;
      GLOADAB(kn * 64)
    }
#pragma unroll
    for (int kk = 0; kk < 2; ++kk) {
      bf16x8 af[4], bfr[4];
#pragma unroll
      for (int m = 0; m < 4; ++m) af[m] = *(const bf16x8*)&As[(wr * 64 + m * 16 + fr) * 72 + kk * 32 + fq * 8];
#pragma unroll
      for (int n = 0; n < 4; ++n) bfr[n] = *(const bf16x8*)&Bs[(wc * 64 + n * 16 + fr) * 72 + kk * 32 + fq * 8];
#pragma unroll
      for (int m = 0; m < 4; ++m)
#pragma unroll
        for (int n = 0; n < 4; ++n) acc[m][n] = mfma16(af[m], bfr[n], acc[m][n]);
    }
  }
  if (MODE == 1) {
    u16* Z = (u16*)(p.ws + OFF_Z);
    float* LR = (float*)(p.ws + OFF_LR);
    const float* ROPE = (const float*)(p.ws + OFF_ROPE);
    const bool is_sample = (mt * 128) >= NP_TOK;
    if (is_sample && nt < 5) {
#pragma unroll
      for (int m = 0; m < 4; ++m)
#pragma unroll
        for (int j = 0; j < 4; ++j) {
          int grow = mt * 128 + wr * 64 + m * 16 + fq * 4 + j;
          int pos = (grow - NP_TOK) & 4095;
          int prow = pos >> 6, pcol = pos & 63;
          float c0 = ROPE[prow * 16 + fr], s0 = ROPE[1024 + prow * 16 + fr];
          float c1 = ROPE[pcol * 16 + fr], s1 = ROPE[1024 + pcol * 16 + fr];
          float x1 = acc[m][0][j], x2 = acc[m][1][j];
          acc[m][0][j] = x1 * c0 - x2 * s0;
          acc[m][1][j] = x2 * c0 + x1 * s0;
          x1 = acc[m][2][j]; x2 = acc[m][3][j];
          acc[m][2][j] = x1 * c1 - x2 * s1;
          acc[m][3][j] = x2 * c1 + x1 * s1;
        }
    }
#pragma unroll
    for (int m = 0; m < 4; ++m)
#pragma unroll
      for (int n = 0; n < 4; ++n)
#pragma unroll
        for (int j = 0; j < 4; ++j) {
          int grow = mt * 128 + wr * 64 + m * 16 + fq * 4 + j;
          int gcol = nt * 128 + wc * 64 + n * 16 + fr;
          float val = acc[m][n][j];
          if (gcol < ZW) Z[(size_t)grow * ZW + gcol] = f2bf(val);
          if (!is_sample) {
            if (nt == 4) p.out[OUT_NK + (size_t)grow * 128 + (gcol - C_K)] = val;
            if (nt == 5) p.out[OUT_NV + (size_t)grow * 128 + (gcol - C_V)] = val;
          }
          if (nt == 18 && gcol < C_ZG) LR[(size_t)grow * 32 + (gcol - C_LR)] = val;
        }
  } else {
    const float* MOD = (const float*)(p.ws + OFF_MOD);
    const float* gate = MOD + mod_idx(mt * 128) * 3072 + 2048;
#pragma unroll
    for (int m = 0; m < 4; ++m)
#pragma unroll
      for (int n = 0; n < 4; ++n)
#pragma unroll
        for (int j = 0; j < 4; ++j) {
          int grow = mt * 128 + wr * 64 + m * 16 + fq * 4 + j;
          int gcol = nt * 128 + wc * 64 + n * 16 + fr;
          float xv = xrow_ptr(p, grow)[gcol];
          p.out[OUT_Y + (size_t)grow * DM + gcol] = xv + gate[gcol] * acc[m][n][j];
        }
  }
}

__device__ void attn_item(const Params& p, int item, unsigned char* smem) {
  u16* Ks = (u16*)smem;
  u16* Vt = Ks + 64 * 72;
  float* Os = (float*)(Vt + 64 * 72);
  const u16* Z = (const u16*)(p.ws + OFF_Z);
  u16* Y = (u16*)(p.ws + OFF_HY);
  const int tid = threadIdx.x, lane = tid & 63, w = tid >> 6, r = lane & 31, hh = lane >> 5;
  const bool latent = item < 1024;
  int b, kvh, g, qb, seq0;
  if (latent) { g = item & 3; qb = (item >> 2) & 31; kvh = (item >> 7) & 1; b = item >> 8; seq0 = NP_TOK + b * 4096; }
  else { int it = item - 1024; g = it & 3; qb = (it >> 2) & 1; kvh = (it >> 3) & 1; b = it >> 4; seq0 = b * 256; }
  const int h = kvh * 4 + g;
  const int t0 = seq0 + qb * 128;
  bf16x8 qf[4];
  {
    const u16* qptr = Z + (size_t)(t0 + w * 32 + r) * ZW + C_Q + h * 64 + hh * 8;
#pragma unroll
    for (int ks = 0; ks < 4; ++ks) qf[ks] = *(const bf16x8*)(qptr + ks * 16);
  }
  float m = p.sink[h], l = 1.f;
  f32x16 O0, O1;
#pragma unroll
  for (int i = 0; i < 16; ++i) { O0[i] = 0.f; O1[i] = 0.f; }
  const int ntiles = latent ? 14 : 4;
  const int qpos = qb * 128 + w * 32 + r;
  const int key = tid >> 2, dq = (tid & 3) * 16;
  for (int ti = 0; ti < ntiles; ++ti) {
    bool from_cache = false, masked = false;
    int kbase;
    if (latent) {
      if (ti < 6) {
        kbase = (qb - 1) * 128 + ti * 64;
        if (kbase < 0 || kbase >= 4096) continue;
        masked = true;
      } else { from_cache = true; kbase = (ti - 6) * 64; }
    } else kbase = ti * 64;
    if (!from_cache) {
      const u16* src = Z + (size_t)(seq0 + kbase + key) * ZW + kvh * 64 + dq;
      uint4 k0 = *(const uint4*)(src + C_K), k1 = *(const uint4*)(src + C_K + 8);
      uint4 v0 = *(const uint4*)(src + C_V), v1 = *(const uint4*)(src + C_V + 8);
      *(uint4*)&Ks[key * 72 + dq] = k0;
      *(uint4*)&Ks[key * 72 + dq + 8] = k1;
#define VTW(e, val) Vt[(dq + 2 * (e)) * 72 + key] = (u16)((val) & 0xffffu); Vt[(dq + 2 * (e) + 1) * 72 + key] = (u16)((val) >> 16);
      VTW(0, v0.x) VTW(1, v0.y) VTW(2, v0.z) VTW(3, v0.w) VTW(4, v1.x) VTW(5, v1.y) VTW(6, v1.z) VTW(7, v1.w)
    } else {
      size_t off = ((size_t)(b * 512 + kbase + key) * 2 + kvh) * 64 + dq;
      const float4* ksrc = (const float4*)(p.cache_k + off);
      const float4* vsrc = (const float4*)(p.cache_v + off);
      float4 k0 = ksrc[0], k1 = ksrc[1], k2 = ksrc[2], k3 = ksrc[3];
      float4 v0 = vsrc[0], v1 = vsrc[1], v2 = vsrc[2], v3 = vsrc[3];
      *(uint4*)&Ks[key * 72 + dq] = make_uint4(pack2(k0.x, k0.y), pack2(k0.z, k0.w), pack2(k1.x, k1.y), pack2(k1.z, k1.w));
      *(uint4*)&Ks[key * 72 + dq + 8] = make_uint4(pack2(k2.x, k2.y), pack2(k2.z, k2.w), pack2(k3.x, k3.y), pack2(k3.z, k3.w));
#define VTF(e, val) Vt[(dq + (e)) * 72 + key] = f2bf(val);
      VTF(0, v0.x) VTF(1, v0.y) VTF(2, v0.z) VTF(3, v0.w) VTF(4, v1.x) VTF(5, v1.y) VTF(6, v1.z) VTF(7, v1.w)
      VTF(8, v2.x) VTF(9, v2.y) VTF(10, v2.z) VTF(11, v2.w) VTF(12, v3.x) VTF(13, v3.y) VTF(14, v3.z) VTF(15, v3.w)
    }
    __syncthreads();
    f32x16 S[2];
#pragma unroll
    for (int mb = 0; mb < 2; ++mb) {
#pragma unroll
      for (int i = 0; i < 16; ++i) S[mb][i] = 0.f;
#pragma unroll
      for (int ks = 0; ks < 4; ++ks) {
        bf16x8 a = *(const bf16x8*)&Ks[(mb * 32 + r) * 72 + ks * 16 + hh * 8];
        S[mb] = mfma32(a, qf[ks], S[mb]);
      }
    }
    float mx = -3.0e38f;
#pragma unroll
    for (int mb = 0; mb < 2; ++mb)
#pragma unroll
      for (int i = 0; i < 16; ++i) {
        float s = S[mb][i] * 0.125f;
        if (masked) {
          int kpos = kbase + mb * 32 + rowmap(i, hh);
          int d = qpos - kpos;
          if (d > 128 || d < -128) s = -1e30f;
        }
        S[mb][i] = s;
        mx = fmaxf(mx, s);
      }
    mx = fmaxf(mx, __shfl_xor(mx, 32));
    const float mnew = fmaxf(m, mx);
    const float alpha = __expf(m - mnew);
    float rs = 0.f;
#pragma unroll
    for (int mb = 0; mb < 2; ++mb)
#pragma unroll
      for (int i = 0; i < 16; ++i) {
        float pv = __expf(S[mb][i] - mnew);
        S[mb][i] = pv;
        rs += pv;
      }
    rs += __shfl_xor(rs, 32);
    l = l * alpha + rs;
    m = mnew;
#pragma unroll
    for (int i = 0; i < 16; ++i) { O0[i] *= alpha; O1[i] *= alpha; }
#pragma unroll
    for (int mb = 0; mb < 2; ++mb)
#pragma unroll
      for (int s = 0; s < 2; ++s) {
        u32x4 pku;
        pku.x = pack2(S[mb][8 * s + 0], S[mb][8 * s + 1]);
        pku.y = pack2(S[mb][8 * s + 2], S[mb][8 * s + 3]);
        pku.z = pack2(S[mb][8 * s + 4], S[mb][8 * s + 5]);
        pku.w = pack2(S[mb][8 * s + 6], S[mb][8 * s + 7]);
        const bf16x8 pkv = __builtin_bit_cast(bf16x8, pku);
        const int kk = mb * 32 + 16 * s + 4 * hh;
        {
          uint2 q0 = *(const uint2*)&Vt[r * 72 + kk];
          uint2 q1 = *(const uint2*)&Vt[r * 72 + kk + 8];
          u32x4 au; au.x = q0.x; au.y = q0.y; au.z = q1.x; au.w = q1.y;
          O0 = mfma32(__builtin_bit_cast(bf16x8, au), pkv, O0);
        }
        {
          uint2 q0 = *(const uint2*)&Vt[(32 + r) * 72 + kk];
          uint2 q1 = *(const uint2*)&Vt[(32 + r) * 72 + kk + 8];
          u32x4 au; au.x = q0.x; au.y = q0.y; au.z = q1.x; au.w = q1.y;
          O1 = mfma32(__builtin_bit_cast(bf16x8, au), pkv, O1);
        }
      }
    __syncthreads();
  }
  const float inv = 1.f / l;
  float* Ow = Os + w * 32 * 68;
#pragma unroll
  for (int i = 0; i < 16; ++i) {
    Ow[r * 68 + rowmap(i, hh)] = O0[i] * inv;
    Ow[r * 68 + 32 + rowmap(i, hh)] = O1[i] * inv;
  }
  __syncthreads();
#pragma unroll
  for (int i = 0; i < 4; ++i) {
    int idx = lane + 64 * i;
    int row = idx >> 3, c8 = (idx & 7) * 8;
    int t = t0 + w * 32 + row;
    float4 o0 = *(const float4*)&Ow[row * 68 + c8];
    float4 o1 = *(const float4*)&Ow[row * 68 + c8 + 4];
    uint4 za = *(const uint4*)(Z + (size_t)t * ZW + C_ZA + h * 64 + c8);
    uint4 yo;
    yo.x = pack2(o0.x * siluf(bflo(za.x)), o0.y * siluf(bfhi(za.x)));
    yo.y = pack2(o0.z * siluf(bflo(za.y)), o0.w * siluf(bfhi(za.y)));
    yo.z = pack2(o1.x * siluf(bflo(za.z)), o1.y * siluf(bfhi(za.z)));
    yo.w = pack2(o1.z * siluf(bflo(za.w)), o1.w * siluf(bfhi(za.w)));
    *(uint4*)(Y + (size_t)t * DM + h * 64 + c8) = yo;
  }
  __syncthreads();
}

__device__ __forceinline__ void gla_gates(const Params& p, int t0, int h, float* part, float (&gcf)[16],
                                          float (&gcb)[16], float& gtf, float& gtb) {
  const int tid = threadIdx.x, dk = tid & 63, tq = tid >> 6;
  const float* LR = (const float*)(p.ws + OFF_LR);
  float wf[16], wb[16];
#pragma unroll
  for (int rr = 0; rr < 16; ++rr) {
    wf[rr] = p.w_gk_f[rr * 256 + h * 64 + dk];
    wb[rr] = p.w_gk_b[rr * 256 + h * 64 + dk];
  }
  const float bf = p.b_gk_f[h * 64 + dk], bb = p.b_gk_b[h * 64 + dk];
#pragma unroll
  for (int j = 0; j < 16; ++j) {
    const float4* lr4 = (const float4*)(LR + (size_t)(t0 + tq * 16 + j) * 32);
    float4 a0 = lr4[0], a1 = lr4[1], a2 = lr4[2], a3 = lr4[3];
    float4 c0 = lr4[4], c1 = lr4[5], c2 = lr4[6], c3 = lr4[7];
    float pf = bf + a0.x * wf[0] + a0.y * wf[1] + a0.z * wf[2] + a0.w * wf[3] + a1.x * wf[4] + a1.y * wf[5] +
               a1.z * wf[6] + a1.w * wf[7] + a2.x * wf[8] + a2.y * wf[9] + a2.z * wf[10] + a2.w * wf[11] +
               a3.x * wf[12] + a3.y * wf[13] + a3.z * wf[14] + a3.w * wf[15];
    float pb = bb + c0.x * wb[0] + c0.y * wb[1] + c0.z * wb[2] + c0.w * wb[3] + c1.x * wb[4] + c1.y * wb[5] +
               c1.z * wb[6] + c1.w * wb[7] + c2.x * wb[8] + c2.y * wb[9] + c2.z * wb[10] + c2.w * wb[11] +
               c3.x * wb[12] + c3.y * wb[13] + c3.z * wb[14] + c3.w * wb[15];
    gcf[j] = logsigf(pf) * 0.0625f;
    gcb[j] = logsigf(pb) * 0.0625f;
  }
#pragma unroll
  for (int j = 1; j < 16; ++j) gcf[j] += gcf[j - 1];
#pragma unroll
  for (int j = 14; j >= 0; --j) gcb[j] += gcb[j + 1];
  part[tq * 64 + dk] = gcf[15];
  part[(4 + tq) * 64 + dk] = gcb[0];
  __syncthreads();
  float offf = 0.f, offb = 0.f;
  gtf = 0.f; gtb = 0.f;
#pragma unroll
  for (int q = 0; q < 4; ++q) {
    float a = part[q * 64 + dk], bq = part[(4 + q) * 64 + dk];
    gtf += a; gtb += bq;
    if (q < tq) offf += a;
    if (q > tq) offb += bq;
  }
#pragma unroll
  for (int j = 0; j < 16; ++j) { gcf[j] += offf; gcb[j] += offb; }
}

__device__ __forceinline__ void stage_vt(const u16* Z, int t0, int h, u16* Vt) {
  const int tid = threadIdx.x;
  const int tok = tid >> 2, dq = (tid & 3) * 32;
  const uint4* src = (const uint4*)(Z + (size_t)(t0 + tok) * ZW + C_VG + h * 128 + dq);
#pragma unroll
  for (int i = 0; i < 4; ++i) {
    uint4 u = src[i];
#define VTG(e, val) Vt[(dq + i * 8 + 2 * (e)) * 72 + tok] = (u16)((val) & 0xffffu); Vt[(dq + i * 8 + 2 * (e) + 1) * 72 + tok] = (u16)((val) >> 16);
    VTG(0, u.x) VTG(1, u.y) VTG(2, u.z) VTG(3, u.w)
  }
}

__device__ void gla_ds_task(const Params& p, int task, unsigned char* smem) {
  const int cgk = task >> 2, h = task & 3, t0 = cgk * 64;
  u16* KeF = (u16*)smem;
  u16* KeB = KeF + 64 * 72;
  u16* Vt = KeB + 64 * 72;
  float* part = (float*)(Vt + 128 * 72);
  const u16* Z = (const u16*)(p.ws + OFF_Z);
  float* DST = p.out;
  float* DEC = (float*)(p.ws + OFF_DEC);
  const int tid = threadIdx.x, lane = tid & 63, w = tid >> 6, r = lane & 31, hh = lane >> 5;
  const int dk = tid & 63, tq = tid >> 6;
  float gcf[16], gcb[16], gtf, gtb;
  gla_gates(p, t0, h, part, gcf, gcb, gtf, gtb);
#pragma unroll
  for (int j = 0; j < 16; ++j) {
    int tok = tq * 16 + j;
    float k = bf2f(Z[(size_t)(t0 + tok) * ZW + C_KG + h * 64 + dk]);
    KeF[dk * 72 + tok] = f2bf(k * __expf(gtf - gcf[j]));
    KeB[dk * 72 + tok] = f2bf(k * __expf(gtb - gcb[j]));
  }
  if (tq == 0) {
    DEC[(size_t)(task * 2 + 0) * 64 + dk] = __expf(gtf);
    DEC[(size_t)(task * 2 + 1) * 64 + dk] = __expf(gtb);
  }
  stage_vt(Z, t0, h, Vt);
  __syncthreads();
#pragma unroll
  for (int dir = 0; dir < 2; ++dir) {
    const u16* Ke = dir ? KeB : KeF;
#pragma unroll
    for (int nb = 0; nb < 2; ++nb) {
      f32x16 acc;
#pragma unroll
      for (int i = 0; i < 16; ++i) acc[i] = 0.f;
#pragma unroll
      for (int ks = 0; ks < 4; ++ks) {
        bf16x8 a = *(const bf16x8*)&Vt[(w * 32 + r) * 72 + ks * 16 + hh * 8];
        bf16x8 bq = *(const bf16x8*)&Ke[(nb * 32 + r) * 72 + ks * 16 + hh * 8];
        acc = mfma32(a, bq, acc);
      }
      float* dst = DST + ((size_t)(task * 2 + dir) * 128) * 64 + nb * 32 + r;
#pragma unroll
      for (int i = 0; i < 16; ++i) dst[(size_t)(w * 32 + rowmap(i, hh)) * 64] = acc[i];
    }
  }
  __syncthreads();
}

__device__ void gla_scan_task(const Params& p, int task) {
  const float* DST = p.out;
  const float* DEC = (const float*)(p.ws + OFF_DEC);
  u16* SPT = (u16*)(p.ws + OFF_SPT);
  const int tid = threadIdx.x;
  int b, h, dir, part, n, cgbase;
  bool sample;
  if (task < 256) { int chain = task >> 3; part = task & 7; b = chain >> 3; h = (chain >> 1) & 3; dir = chain & 1; n = 64; cgbase = 128 + b * 64; sample = true; }
  else { int tt = task - 256; int chain = tt >> 3; part = tt & 7; b = chain >> 3; h = (chain >> 1) & 3; dir = chain & 1; n = 4; cgbase = b * 4; sample = false; }
  const int e4 = part * 256 + tid;
  const int dv = e4 >> 4, dk4 = (e4 & 15) * 4;
  float4 s = make_float4(0.f, 0.f, 0.f, 0.f);
  const size_t sbase = ((size_t)((b * 2 + dir) * 4 + h)) * 8192;
  if (sample) {
    const float* sg = p.state_gla + sbase;
    s.x = sg[(dk4 + 0) * 128 + dv]; s.y = sg[(dk4 + 1) * 128 + dv];
    s.z = sg[(dk4 + 2) * 128 + dv]; s.w = sg[(dk4 + 3) * 128 + dv];
  }
#pragma unroll 4
  for (int i = 0; i < n; ++i) {
    int c = dir ? (n - 1 - i) : i;
    size_t idx = (size_t)((cgbase + c) * 4 + h) * 2 + dir;
    float4 d = *(const float4*)(DST + idx * 8192 + (size_t)e4 * 4);
    float4 dc = *(const float4*)(DEC + idx * 64 + dk4);
    *(uint2*)(SPT + idx * 8192 + (size_t)e4 * 4) = make_uint2(pack2(s.x, s.y), pack2(s.z, s.w));
    s.x = dc.x * s.x + d.x; s.y = dc.y * s.y + d.y; s.z = dc.z * s.z + d.z; s.w = dc.w * s.w + d.w;
  }
  if (!sample) {
    float* ns = p.out + OUT_NS + sbase;
    ns[(dk4 + 0) * 128 + dv] = s.x; ns[(dk4 + 1) * 128 + dv] = s.y;
    ns[(dk4 + 2) * 128 + dv] = s.z; ns[(dk4 + 3) * 128 + dv] = s.w;
  }
}

__device__ void gla_out_task(const Params& p, int task, unsigned char* smem) {
  const int cgk = task >> 2, h = task & 3, t0 = cgk * 64;
  u16* QdF = (u16*)smem;
  u16* QdB = QdF + 64 * 72;
  u16* KiF = QdB + 64 * 72;
  u16* KiB = KiF + 64 * 72;
  u16* Vt = KiB + 64 * 72;
  float* part = (float*)(Vt + 128 * 72);
  float* ssq = part + 512;
  float* Os = (float*)smem;
  const u16* Z = (const u16*)(p.ws + OFF_Z);
  const u16* SPT = (const u16*)(p.ws + OFF_SPT);
  u16* Y = (u16*)(p.ws + OFF_HY);
  const int tid = threadIdx.x, lane = tid & 63, w = tid >> 6, r = lane & 31, hh = lane >> 5;
  const int dk = tid & 63, tq = tid >> 6;
  {
    float gcf[16], gcb[16], gtf, gtb;
    gla_gates(p, t0, h, part, gcf, gcb, gtf, gtb);
#pragma unroll
    for (int j = 0; j < 16; ++j) {
      int tok = tq * 16 + j;
      const u16* zr = Z + (size_t)(t0 + tok) * ZW + h * 64 + dk;
      float q = bf2f(zr[C_QG]) * 0.125f, k = bf2f(zr[C_KG]);
      float ef = __expf(gcf[j]), eb = __expf(gcb[j]);
      QdF[tok * 72 + dk] = f2bf(q * ef);
      QdB[tok * 72 + dk] = f2bf(q * eb);
      KiF[tok * 72 + dk] = f2bf(k / ef);
      KiB[tok * 72 + dk] = f2bf(k / eb);
    }
  }
  stage_vt(Z, t0, h, Vt);
  __syncthreads();
  const int ib = w & 1, dh = w >> 1;
  bf16x8 qF[4], qB[4];
#pragma unroll
  for (int ks = 0; ks < 4; ++ks) {
    qF[ks] = *(const bf16x8*)&QdF[(ib * 32 + r) * 72 + ks * 16 + hh * 8];
    qB[ks] = *(const bf16x8*)&QdB[(ib * 32 + r) * 72 + ks * 16 + hh * 8];
  }
  f32x16 comb[2];
  const int ii = ib * 32 + r;
#pragma unroll
  for (int mb = 0; mb < 2; ++mb) {
    f32x16 xf, xb;
#pragma unroll
    for (int i = 0; i < 16; ++i) { xf[i] = 0.f; xb[i] = 0.f; }
#pragma unroll
    for (int ks = 0; ks < 4; ++ks) {
      bf16x8 a = *(const bf16x8*)&KiF[(mb * 32 + r) * 72 + ks * 16 + hh * 8];
      xf = mfma32(a, qF[ks], xf);
      bf16x8 a2 = *(const bf16x8*)&KiB[(mb * 32 + r) * 72 + ks * 16 + hh * 8];
      xb = mfma32(a2, qB[ks], xb);
    }
#pragma unroll
    for (int i = 0; i < 16; ++i) {
      int jj = mb * 32 + rowmap(i, hh);
      comb[mb][i] = ((ii >= jj) ? xf[i] : 0.f) + ((ii <= jj) ? xb[i] : 0.f);
    }
  }
  f32x16 o[2];
#pragma unroll
  for (int db = 0; db < 2; ++db) {
#pragma unroll
    for (int i = 0; i < 16; ++i) o[db][i] = 0.f;
    const int dvrow = dh * 64 + db * 32 + r;
#pragma unroll
    for (int mb = 0; mb < 2; ++mb)
#pragma unroll
      for (int s = 0; s < 2; ++s) {
        u32x4 pku;
        pku.x = pack2(comb[mb][8 * s + 0], comb[mb][8 * s + 1]);
        pku.y = pack2(comb[mb][8 * s + 2], comb[mb][8 * s + 3]);
        pku.z = pack2(comb[mb][8 * s + 4], comb[mb][8 * s + 5]);
        pku.w = pack2(comb[mb][8 * s + 6], comb[mb][8 * s + 7]);
        const int kk = mb * 32 + 16 * s + 4 * hh;
        uint2 q0 = *(const uint2*)&Vt[dvrow * 72 + kk];
        uint2 q1 = *(const uint2*)&Vt[dvrow * 72 + kk + 8];
        u32x4 au; au.x = q0.x; au.y = q0.y; au.z = q1.x; au.w = q1.y;
        o[db] = mfma32(__builtin_bit_cast(bf16x8, au), __builtin_bit_cast(bf16x8, pku), o[db]);
      }
    const u16* sf = SPT + ((size_t)(task * 2 + 0) * 128 + dvrow) * 64 + hh * 8;
    const u16* sb = SPT + ((size_t)(task * 2 + 1) * 128 + dvrow) * 64 + hh * 8;
#pragma unroll
    for (int ks = 0; ks < 4; ++ks) {
      bf16x8 a = *(const bf16x8*)(sf + ks * 16);
      o[db] = mfma32(a, qF[ks], o[db]);
      bf16x8 a2 = *(const bf16x8*)(sb + ks * 16);
      o[db] = mfma32(a2, qB[ks], o[db]);
    }
  }
  float ss = 0.f;
#pragma unroll
  for (int db = 0; db < 2; ++db)
#pragma unroll
    for (int i = 0; i < 16; ++i) ss += o[db][i] * o[db][i];
  ss += __shfl_xor(ss, 32);
  if (hh == 0) ssq[dh * 64 + ii] = ss;
  __syncthreads();
  const float rstd = rsqrtf((ssq[ii] + ssq[64 + ii]) * (1.f / 128.f) + EPSV);
#pragma unroll
  for (int db = 0; db < 2; ++db)
#pragma unroll
    for (int i = 0; i < 16; ++i) Os[ii * 132 + dh * 64 + db * 32 + rowmap(i, hh)] = o[db][i] * rstd;
  __syncthreads();
#pragma unroll
  for (int i = 0; i < 4; ++i) {
    int idx = tid + 256 * i;
    int tok = idx >> 4, c8 = (idx & 15) * 8;
    float4 o0 = *(const float4*)&Os[tok * 132 + c8];
    float4 o1 = *(const float4*)&Os[tok * 132 + c8 + 4];
    float4 g0 = *(const float4*)(p.gla_norm_g + c8);
    float4 g1 = *(const float4*)(p.gla_norm_g + c8 + 4);
    uint4 zg = *(const uint4*)(Z + (size_t)(t0 + tok) * ZW + C_ZG + h * 128 + c8);
    uint4 yo;
    yo.x = pack2(o0.x * g0.x * siluf(bflo(zg.x)), o0.y * g0.y * siluf(bfhi(zg.x)));
    yo.y = pack2(o0.z * g0.z * siluf(bflo(zg.y)), o0.w * g0.w * siluf(bfhi(zg.y)));
    yo.z = pack2(o1.x * g1.x * siluf(bflo(zg.z)), o1.y * g1.y * siluf(bfhi(zg.z)));
    yo.w = pack2(o1.z * g1.z * siluf(bflo(zg.w)), o1.w * g1.w * siluf(bfhi(zg.w)));
    *(uint4*)(Y + (size_t)(t0 + tok) * DM + 512 + h * 128 + c8) = yo;
  }
  __syncthreads();
}

__device__ void final_rows(const Params& p) {
  const int lane = threadIdx.x & 63, w = threadIdx.x >> 6;
  for (int row = blockIdx.x * 4 + w; row < T_TOK; row += gridDim.x * 4) {
    float* x = p.out + OUT_Y + (size_t)row * DM;
    float4 v[4];
    float ss = 0.f;
#pragma unroll
    for (int i = 0; i < 4; ++i) {
      v[i] = *(const float4*)(x + i * 256 + lane * 4);
      ss += v[i].x * v[i].x + v[i].y * v[i].y + v[i].z * v[i].z + v[i].w * v[i].w;
    }
#pragma unroll
    for (int o = 32; o >= 1; o >>= 1) ss += __shfl_xor(ss, o);
    const float rstd = rsqrtf(ss * (1.f / 1024.f) + EPSV);
#pragma unroll
    for (int i = 0; i < 4; ++i) {
      int col = i * 256 + lane * 4;
      float4 g = *(const float4*)(p.final_norm_g + col);
      float4 o4 = make_float4(v[i].x * rstd * g.x, v[i].y * rstd * g.y, v[i].z * rstd * g.z, v[i].w * rstd * g.w);
      *(float4*)(x + col) = o4;
    }
  }
}

__global__ void __launch_bounds__(256, 2) mega(Params p) {
  __shared__ __attribute__((aligned(16))) unsigned char smem[LDS_BYTES];
  cg::grid_group grid = cg::this_grid();
  const int nb = gridDim.x;
  for (int t = blockIdx.x; t < 192 + 736 + 256 + 1; t += nb) {
    if (t < 192) p0_adaln(p, t, smem);
    else if (t < 192 + 736) { int q = t - 192; p0_transpose(p.w_in, ZW, (u16*)(p.ws + OFF_WINT), q / 46, q % 46, smem); }
    else if (t < 192 + 736 + 256) { int q = t - 928; p0_transpose(p.w_out, 1024, (u16*)(p.ws + OFF_WOUTT), q >> 4, q & 15, smem); }
    else p0_rope(p);
  }
  grid.sync();
  p1_rows(p);
  grid.sync();
  for (int t = blockIdx.x; t < 192 * 23; t += nb)
    gemm_tile<1>(p, (const u16*)(p.ws + OFF_HY), (const u16*)(p.ws + OFF_WINT), t / 23, t % 23, smem);
  grid.sync();
  for (int t = blockIdx.x; t < 1536 + 1536; t += nb) {
    if (t < 1536) gla_ds_task(p, t, smem);
    else attn_item(p, t - 1536, smem);
  }
  grid.sync();
  for (int t = blockIdx.x; t < 2304; t += nb) gla_scan_task(p, t);
  grid.sync();
  for (int t = blockIdx.x; t < 1536; t += nb) gla_out_task(p, t, smem);
  grid.sync();
  for (int t = blockIdx.x; t < 192 * 8; t += nb)
    gemm_tile<2>(p, (const u16*)(p.ws + OFF_HY), (const u16*)(p.ws + OFF_WOUTT), t >> 3, t & 7, smem);
  grid.sync();
  final_rows(p);
}

extern "C" void kernel_launch(void* const* d_in, const int* in_sizes, int n_in, void* d_out, int out_size,
                              void* d_ws, size_t ws_size, hipStream_t stream) {
  static int grid_blocks = 0;
  if (!grid_blocks) {
    int dev = 0, cus = 0, per_cu = 0;
    hipGetDevice(&dev);
    hipDeviceGetAttribute(&cus, hipDeviceAttributeMultiprocessorCount, dev);
    hipOccupancyMaxActiveBlocksPerMultiprocessor(&per_cu, mega, 256, 0);
    if (per_cu < 1) per_cu = 1;
    if (per_cu > 2) per_cu = 2;
    grid_blocks = cus * per_cu;
  }
  Params p{};
  const float** pp = (const float**)&p;
  for (int i = 0; i < 19; ++i) pp[i] = (const float*)d_in[i];
  p.out = (float*)d_out;
  p.ws = (unsigned char*)d_ws;
  void* args[] = {&p};
  hipError_t e = hipLaunchCooperativeKernel((void*)mega, dim3(grid_blocks), dim3(256), args, 0, stream);
  if (e != hipSuccess) fprintf(stderr, "cooperative launch failed: %s (grid %d)\n", hipGetErrorString(e), grid_blocks);
}
```

```cpp
#include <hip/hip_runtime.h>
#include <hip/hip_cooperative_groups.h>
#include <cstdio>
namespace cg = cooperative_groups;

typedef unsigned short u16;
using bf16x8 = __attribute__((ext_vector_type(8))) short;
using f32x4  = __attribute__((ext_vector_type(4))) float;
using f32x16 = __attribute__((ext_vector_type(16))) float;
using u32x4 = __attribute__((ext_vector_type(4))) unsigned;

#define T_TOK   24576
#define NP_TOK  8192
#define DM      1024
#define ZW      2848
#define ZWP     2944
#define EPSV    1e-6f

#define C_Q   0
#define C_K   512
#define C_V   640
#define C_ZA  768
#define C_QG  1280
#define C_KG  1536
#define C_VG  1792
#define C_LR  2304
#define C_ZG  2336

#define OFF_MOD   0ull
#define OFF_ROPE  65536ull
#define OFF_BAR   81920ull
#define OFF_DEC   131072ull
#define OFF_LR    1048576ull
#define OFF_WINT  4194304ull
#define OFF_WOUTT 10223616ull
#define OFF_HY    12582912ull
#define OFF_Z     62914560ull
#define OFF_SPT   202899456ull

#define OUT_Y     0
#define OUT_NK    25165824
#define OUT_NV    26214400
#define OUT_NS    27262976

#define LDS_BYTES 59392

struct Params {
  const float *xp, *xs, *c, *cache_k, *cache_v, *state_gla, *c_ctx, *w_mod, *b_mod, *norm_g, *w_in,
              *w_gk_f, *b_gk_f, *w_gk_b, *b_gk_b, *sink, *gla_norm_g, *w_out, *final_norm_g;
  float* out;
  unsigned char* ws;
};

__device__ __forceinline__ u16 f2bf(float f) {
  unsigned u = __float_as_uint(f);
  u += 0x7fffu + ((u >> 16) & 1u);
  return (u16)(u >> 16);
}
__device__ __forceinline__ float bf2f(u16 h) { return __uint_as_float(((unsigned)h) << 16); }
__device__ __forceinline__ unsigned pack2(float a, float b) { return (unsigned)f2bf(a) | ((unsigned)f2bf(b) << 16); }
__device__ __forceinline__ float bflo(unsigned u) { return __uint_as_float(u << 16); }
__device__ __forceinline__ float bfhi(unsigned u) { return __uint_as_float(u & 0xffff0000u); }
__device__ __forceinline__ float siluf(float x) { return x / (1.f + __expf(-x)); }
__device__ __forceinline__ float logsigf(float x) { return fminf(x, 0.f) - __logf(1.f + __expf(-fabsf(x))); }
__device__ __forceinline__ int rowmap(int reg, int hh) { return (reg & 3) + 8 * (reg >> 2) + 4 * hh; }

__device__ __forceinline__ f32x16 mfma32(bf16x8 a, bf16x8 b, f32x16 c) {
  return __builtin_amdgcn_mfma_f32_32x32x16_bf16(a, b, c, 0, 0, 0);
}
__device__ __forceinline__ f32x4 mfma16(bf16x8 a, bf16x8 b, f32x4 c) {
  return __builtin_amdgcn_mfma_f32_16x16x32_bf16(a, b, c, 0, 0, 0);
}
__device__ __forceinline__ const float* xrow_ptr(const Params& p, int t) {
  return (t < NP_TOK) ? (p.xp + (size_t)t * DM) : (p.xs + (size_t)(t - NP_TOK) * DM);
}
__device__ __forceinline__ int mod_idx(int t) { return (t < NP_TOK) ? 0 : 1 + ((t - NP_TOK) >> 12); }

__device__ const double kFreq[16] = {
  1.0, 0.5623413251903491, 0.31622776601683794, 0.1778279410038923, 0.1, 0.05623413251903491,
  0.03162277660168379, 0.01778279410038923, 0.01, 0.005623413251903491, 0.0031622776601683794,
  0.0017782794100389228, 0.001, 0.0005623413251903491, 0.00031622776601683794, 0.00017782794100389227};

#define XB_TMO      128
#define XB_XCNT(j)  (256  + 64 * (j))
#define XB_XSUB(j)  (1280 + 64 * (j))
#define XB_XGEN(j)  (2304 + 64 * (j))
#define XB_TOP      3328
#define XB_TOPGEN   3392
#define XCD_BAR_WORDS 3456
#define XB_SPIN_CAP (1u << 18)
#define LAS __attribute__((address_space(3)))

__device__ __forceinline__ unsigned xb_ld(unsigned* p)              { return __hip_atomic_load(p, __ATOMIC_RELAXED, __HIP_MEMORY_SCOPE_AGENT); }
__device__ __forceinline__ unsigned xb_add(unsigned* p, unsigned v) { return __hip_atomic_fetch_add(p, v, __ATOMIC_RELAXED, __HIP_MEMORY_SCOPE_AGENT); }
__device__ __forceinline__ unsigned xb_xcc_id() { return (unsigned)__builtin_amdgcn_s_getreg((3 << 11) | 20) & 0xFu; }
#define XB_SPIN(cond, bar) do { unsigned _sp = 0; while (cond) { __builtin_amdgcn_s_sleep(1); \
    if ((++_sp & 255u) == 0u) { if (xb_ld(&(bar)[XB_TMO])) break; if (_sp > XB_SPIN_CAP) { atomicAdd(&(bar)[XB_TMO], 1u); break; } } } } while (0)

struct XcdBarrier {
    unsigned* bar; unsigned x;
    volatile LAS unsigned* st;
};

__device__ __forceinline__ XcdBarrier xcd_barrier_post(unsigned* bar, volatile LAS unsigned* st) {
    XcdBarrier b; b.bar = bar; b.x = xb_xcc_id(); b.st = st;
    if (threadIdx.x == 0) (void)xb_add(&bar[XB_XCNT(b.x)], 1u);
    return b;
}
__device__ __forceinline__ void xcd_barrier_complete(unsigned* bar, unsigned x, unsigned& nloc, unsigned& nx) {
    const unsigned G = gridDim.x * gridDim.y * gridDim.z;
    unsigned sum, cnt, mine, sp = 0u;
    for (;;) {
        sum = 0u; cnt = 0u; mine = 0u;
#pragma unroll
        for (unsigned j = 0; j < 16; ++j) { const unsigned c = xb_ld(&bar[XB_XCNT(j)]); sum += c; cnt += (c > 0u) ? 1u : 0u; mine = (j == x) ? c : mine; }
        if (sum == G) break;
        __builtin_amdgcn_s_sleep(1);
        if ((++sp & 255u) == 0u) { if (xb_ld(&bar[XB_TMO])) break; if (sp > XB_SPIN_CAP) { atomicAdd(&bar[XB_TMO], 1u); break; } }
    }
    nloc = mine > 0u ? mine : 1u; nx = cnt > 0u ? cnt : 1u;
}

__device__ __forceinline__ void xcd_barrier(const XcdBarrier& b) {
    asm volatile("s_waitcnt vmcnt(0)" ::: "memory");
    __syncthreads();
    if (threadIdx.x == 0) {
        unsigned* bar = b.bar;
        __builtin_amdgcn_s_waitcnt(0);
        unsigned nloc = b.st[0], nx = b.st[1];
        if (nloc == 0u) { xcd_barrier_complete(bar, b.x, nloc, nx); b.st[0] = nloc; b.st[1] = nx; }
        const unsigned old = xb_add(&bar[XB_XSUB(b.x)], 1u);
        const unsigned gen = old / nloc;
        if (old + 1u == (gen + 1u) * nloc) {
            __builtin_amdgcn_fence(__ATOMIC_RELEASE, "agent");
            asm volatile("s_waitcnt vmcnt(0)" ::: "memory");
            const unsigned og = xb_add(&bar[XB_TOP], 1u);
            const unsigned tg = og / nx;
            if (og + 1u == (tg + 1u) * nx) xb_add(&bar[XB_TOPGEN], 1u);
            else XB_SPIN(xb_ld(&bar[XB_TOPGEN]) == tg, bar);
            __builtin_amdgcn_fence(__ATOMIC_ACQUIRE, "agent");
            xb_add(&bar[XB_XGEN(b.x)], 1u);
            asm volatile("s_waitcnt vmcnt(0)" ::: "memory");
        } else {
            XB_SPIN(xb_ld(&bar[XB_XGEN(b.x)]) == gen, bar);
            __builtin_amdgcn_fence(__ATOMIC_ACQUIRE, "agent");
            asm volatile("s_waitcnt vmcnt(0)" ::: "memory");
        }
    }
    __syncthreads();
}


__device__ void p0_adaln(const Params& p, int task, unsigned char* smem) {
  float* sc  = (float*)smem;
  float* red = sc + 5120;
  float* MOD = (float*)(p.ws + OFF_MOD);
  const int tid = threadIdx.x;
  for (int e = tid; e < 5120; e += 256) {
    int i = e >> 10, k = e & 1023;
    float v = (i == 0) ? p.c_ctx[k] : p.c[(i - 1) * 1024 + k];
    sc[e] = siluf(v);
  }
  __syncthreads();
  const int rg = tid >> 2, qd = tid & 3;
  const int c0 = task * 16 + qd * 4;
  float acc[5][4];
#pragma unroll
  for (int i = 0; i < 5; ++i)
#pragma unroll
    for (int j = 0; j < 4; ++j) acc[i][j] = 0.f;
#pragma unroll 4
  for (int it = 0; it < 16; ++it) {
    int row = it * 64 + rg;
    float4 w = *(const float4*)(p.w_mod + (size_t)row * 3072 + c0);
#pragma unroll
    for (int i = 0; i < 5; ++i) {
      float s = sc[i * 1024 + row];
      acc[i][0] += s * w.x; acc[i][1] += s * w.y; acc[i][2] += s * w.z; acc[i][3] += s * w.w;
    }
  }
#pragma unroll
  for (int i = 0; i < 5; ++i)
#pragma unroll
    for (int j = 0; j < 4; ++j) red[rg * 80 + i * 16 + qd * 4 + j] = acc[i][j];
  __syncthreads();
  if (tid < 80) {
    int i = tid >> 4, cc = tid & 15;
    float s = 0.f;
    for (int r = 0; r < 64; ++r) s += red[r * 80 + tid];
    MOD[i * 3072 + task * 16 + cc] = s + p.b_mod[task * 16 + cc];
  }
  __syncthreads();
}

__device__ void p0_transpose(const float* W, int N, u16* WT, int kt, int nt, unsigned char* smem) {
  float* tile = (float*)smem;
  const int tid = threadIdx.x;
  const int r = tid >> 4, c4 = (tid & 15) * 4;
  const int k0 = kt * 64, n0 = nt * 64;
#pragma unroll
  for (int it = 0; it < 4; ++it) {
    int row = r + 16 * it;
    float4 v = make_float4(0.f, 0.f, 0.f, 0.f);
    if (n0 + c4 < N) v = *(const float4*)(W + (size_t)(k0 + row) * N + n0 + c4);
    tile[row * 65 + c4 + 0] = v.x; tile[row * 65 + c4 + 1] = v.y;
    tile[row * 65 + c4 + 2] = v.z; tile[row * 65 + c4 + 3] = v.w;
  }
  __syncthreads();
  const int n = tid >> 2, kq = (tid & 3) * 16;
  unsigned u[8];
#pragma unroll
  for (int j = 0; j < 8; ++j) u[j] = pack2(tile[(kq + 2 * j) * 65 + n], tile[(kq + 2 * j + 1) * 65 + n]);
  uint4* dst = (uint4*)(WT + (size_t)(n0 + n) * 1024 + k0 + kq);
  dst[0] = make_uint4(u[0], u[1], u[2], u[3]);
  dst[1] = make_uint4(u[4], u[5], u[6], u[7]);
  __syncthreads();
}

__device__ void p0_rope(const Params& p) {
  float* ROPE = (float*)(p.ws + OFF_ROPE);
  const int tid = threadIdx.x;
  if (tid < 16) {
    double f = kFreq[tid];
    double x2 = f * f, s = 1.0, c = 1.0;
    for (int n = 10; n >= 1; --n) {
      s = 1.0 - x2 / (double)((2 * n) * (2 * n + 1)) * s;
      c = 1.0 - x2 / (double)((2 * n - 1) * (2 * n)) * c;
    }
    s *= f;
    double cc = 1.0, ss = 0.0;
    for (int pos = 0; pos < 64; ++pos) {
      ROPE[pos * 16 + tid] = (float)cc;
      ROPE[1024 + pos * 16 + tid] = (float)ss;
      double nc = cc * c - ss * s, ns = ss * c + cc * s;
      cc = nc; ss = ns;
    }
  }
}

__device__ void p1_rows(const Params& p) {
  const float* MOD = (const float*)(p.ws + OFF_MOD);
  u16* H = (u16*)(p.ws + OFF_HY);
  const int lane = threadIdx.x & 63, w = threadIdx.x >> 6;
  for (int row = blockIdx.x * 4 + w; row < T_TOK; row += gridDim.x * 4) {
    const float* x = xrow_ptr(p, row);
    const float* md = MOD + mod_idx(row) * 3072;
    float4 v[4];
    float ss = 0.f;
#pragma unroll
    for (int i = 0; i < 4; ++i) {
      v[i] = *(const float4*)(x + i * 256 + lane * 4);
      ss += v[i].x * v[i].x + v[i].y * v[i].y + v[i].z * v[i].z + v[i].w * v[i].w;
    }
#pragma unroll
    for (int o = 32; o >= 1; o >>= 1) ss += __shfl_xor(ss, o);
    const float rstd = rsqrtf(ss * (1.f / 1024.f) + EPSV);
#pragma unroll
    for (int i = 0; i < 4; ++i) {
      int col = i * 256 + lane * 4;
      float4 g = *(const float4*)(p.norm_g + col);
      float4 sh = *(const float4*)(md + col);
      float4 sc = *(const float4*)(md + 1024 + col);
      float h0 = v[i].x * rstd * g.x * (1.f + sc.x) + sh.x;
      float h1 = v[i].y * rstd * g.y * (1.f + sc.y) + sh.y;
      float h2 = v[i].z * rstd * g.z * (1.f + sc.z) + sh.z;
      float h3 = v[i].w * rstd * g.w * (1.f + sc.w) + sh.w;
      uint2 o2 = make_uint2(pack2(h0, h1), pack2(h2, h3));
      *(uint2*)(H + (size_t)row * DM + col) = o2;
    }
  }
}

template <int MODE>
__device__ void gemm_tile(const Params& p, const u16* __restrict__ A, const u16* __restrict__ Bt, int mt, int nt,
                          unsigned char* smem) {
  u16* As = (u16*)smem;
  u16* Bs = As + 128 * 72;
  const int tid = threadIdx.x, lane = tid & 63, wid = tid >> 6;
  const int wr = wid >> 1, wc = wid & 1, fr = lane & 15, fq = lane >> 4;
  f32x4 acc[4][4];
#pragma unroll
  for (int m = 0; m < 4; ++m)
#pragma unroll
    for (int n = 0; n < 4; ++n) acc[m][n] = (f32x4){0.f, 0.f, 0.f, 0.f};
  const int lrw = tid >> 3, lc = (tid & 7) * 8;
  const u16* Ap = A + (size_t)(mt * 128 + lrw) * 1024 + lc;
  const u16* Bp = Bt + (size_t)(nt * 128 + lrw) * 1024 + lc;
  uint4 ra0, ra1, ra2, ra3, rb0, rb1, rb2, rb3;
#define GLOADAB(koff)                                              \
  ra0 = *(const uint4*)(Ap + (size_t)0 * 32 * 1024 + (koff));      \
  ra1 = *(const uint4*)(Ap + (size_t)1 * 32 * 1024 + (koff));      \
  ra2 = *(const uint4*)(Ap + (size_t)2 * 32 * 1024 + (koff));      \
  ra3 = *(const uint4*)(Ap + (size_t)3 * 32 * 1024 + (koff));      \
  rb0 = *(const uint4*)(Bp + (size_t)0 * 32 * 1024 + (koff));      \
  rb1 = *(const uint4*)(Bp + (size_t)1 * 32 * 1024 + (koff));      \
  rb2 = *(const uint4*)(Bp + (size_t)2 * 32 * 1024 + (koff));      \
  rb3 = *(const uint4*)(Bp + (size_t)3 * 32 * 1024 + (koff));
  GLOADAB(0)
  for (int kt = 0; kt < 16; ++kt) {
    __syncthreads();
    *(uint4*)&As[(lrw + 0) * 72 + lc] = ra0;
    *(uint4*)&As[(lrw + 32) * 72 + lc] = ra1;
    *(uint4*)&As[(lrw + 64) * 72 + lc] = ra2;
    *(uint4*)&As[(lrw + 96) * 72 + lc] = ra3;
    *(uint4*)&Bs[(lrw + 0) * 72 + lc] = rb0;
    *(uint4*)&Bs[(lrw + 32) * 72 + lc] = rb1;
    *(uint4*)&Bs[(lrw + 64) * 72 + lc] = rb2;
    *(uint4*)&Bs[(lrw + 96) * 72 + lc] = rb3;
    __syncthreads();
    {
      const int kn = (kt + 1 < 16) ? (kt + 1) : kt;
      GLOADAB(kn * 64)
    }
#pragma unroll
    for (int kk = 0; kk < 2; ++kk) {
      bf16x8 af[4], bfr[4];
#pragma unroll
      for (int m = 0; m < 4; ++m) af[m] = *(const bf16x8*)&As[(wr * 64 + m * 16 + fr) * 72 + kk * 32 + fq * 8];
#pragma unroll
      for (int n = 0; n < 4; ++n) bfr[n] = *(const bf16x8*)&Bs[(wc * 64 + n * 16 + fr) * 72 + kk * 32 + fq * 8];
#pragma unroll
      for (int m = 0; m < 4; ++m)
#pragma unroll
        for (int n = 0; n < 4; ++n) acc[m][n] = mfma16(af[m], bfr[n], acc[m][n]);
    }
  }
  if (MODE == 1) {
    u16* Z = (u16*)(p.ws + OFF_Z);
    float* LR = (float*)(p.ws + OFF_LR);
    const float* ROPE = (const float*)(p.ws + OFF_ROPE);
    const bool is_sample = (mt * 128) >= NP_TOK;
    if (is_sample && nt < 5) {
#pragma unroll
      for (int m = 0; m < 4; ++m)
#pragma unroll
        for (int j = 0; j < 4; ++j) {
          int grow = mt * 128 + wr * 64 + m * 16 + fq * 4 + j;
          int pos = (grow - NP_TOK) & 4095;
          int prow = pos >> 6, pcol = pos & 63;
          float c0 = ROPE[prow * 16 + fr], s0 = ROPE[1024 + prow * 16 + fr];
          float c1 = ROPE[pcol * 16 + fr], s1 = ROPE[1024 + pcol * 16 + fr];
          float x1 = acc[m][0][j], x2 = acc[m][1][j];
          acc[m][0][j] = x1 * c0 - x2 * s0;
          acc[m][1][j] = x2 * c0 + x1 * s0;
          x1 = acc[m][2][j]; x2 = acc[m][3][j];
          acc[m][2][j] = x1 * c1 - x2 * s1;
          acc[m][3][j] = x2 * c1 + x1 * s1;
        }
    }
#pragma unroll
    for (int m = 0; m < 4; ++m)
#pragma unroll
      for (int n = 0; n < 4; ++n)
#pragma unroll
        for (int j = 0; j < 4; ++j) {
          int grow = mt * 128 + wr * 64 + m * 16 + fq * 4 + j;
          int gcol = nt * 128 + wc * 64 + n * 16 + fr;
          float val = acc[m][n][j];
          if (gcol < ZW) Z[(size_t)grow * ZW + gcol] = f2bf(val);
          if (!is_sample) {
            if (nt == 4) p.out[OUT_NK + (size_t)grow * 128 + (gcol - C_K)] = val;
            if (nt == 5) p.out[OUT_NV + (size_t)grow * 128 + (gcol - C_V)] = val;
          }
          if (nt == 18 && gcol < C_ZG) LR[(size_t)grow * 32 + (gcol - C_LR)] = val;
        }
  } else {
    const float* MOD = (const float*)(p.ws + OFF_MOD);
    const float* gate = MOD + mod_idx(mt * 128) * 3072 + 2048;
#pragma unroll
    for (int m = 0; m < 4; ++m)
#pragma unroll
      for (int n = 0; n < 4; ++n)
#pragma unroll
        for (int j = 0; j < 4; ++j) {
          int grow = mt * 128 + wr * 64 + m * 16 + fq * 4 + j;
          int gcol = nt * 128 + wc * 64 + n * 16 + fr;
          float xv = xrow_ptr(p, grow)[gcol];
          p.out[OUT_Y + (size_t)grow * DM + gcol] = xv + gate[gcol] * acc[m][n][j];
        }
  }
}

__device__ void attn_item(const Params& p, int item, unsigned char* smem) {
  u16* Ks = (u16*)smem;
  u16* Vt = Ks + 64 * 72;
  float* Os = (float*)(Vt + 64 * 72);
  const u16* Z = (const u16*)(p.ws + OFF_Z);
  u16* Y = (u16*)(p.ws + OFF_HY);
  const int tid = threadIdx.x, lane = tid & 63, w = tid >> 6, r = lane & 31, hh = lane >> 5;
  const bool latent = item < 1024;
  int b, kvh, g, qb, seq0;
  if (latent) { g = item & 3; qb = (item >> 2) & 31; kvh = (item >> 7) & 1; b = item >> 8; seq0 = NP_TOK + b * 4096; }
  else { int it = item - 1024; g = it & 3; qb = (it >> 2) & 1; kvh = (it >> 3) & 1; b = it >> 4; seq0 = b * 256; }
  const int h = kvh * 4 + g;
  const int t0 = seq0 + qb * 128;
  bf16x8 qf[4];
  {
    const u16* qptr = Z + (size_t)(t0 + w * 32 + r) * ZW + C_Q + h * 64 + hh * 8;
#pragma unroll
    for (int ks = 0; ks < 4; ++ks) qf[ks] = *(const bf16x8*)(qptr + ks * 16);
  }
  float m = p.sink[h], l = 1.f;
  f32x16 O0, O1;
#pragma unroll
  for (int i = 0; i < 16; ++i) { O0[i] = 0.f; O1[i] = 0.f; }
  const int ntiles = latent ? 14 : 4;
  const int qpos = qb * 128 + w * 32 + r;
  const int key = tid >> 2, dq = (tid & 3) * 16;
  for (int ti = 0; ti < ntiles; ++ti) {
    bool from_cache = false, masked = false;
    int kbase;
    if (latent) {
      if (ti < 6) {
        kbase = (qb - 1) * 128 + ti * 64;
        if (kbase < 0 || kbase >= 4096) continue;
        masked = true;
      } else { from_cache = true; kbase = (ti - 6) * 64; }
    } else kbase = ti * 64;
    if (!from_cache) {
      const u16* src = Z + (size_t)(seq0 + kbase + key) * ZW + kvh * 64 + dq;
      uint4 k0 = *(const uint4*)(src + C_K), k1 = *(const uint4*)(src + C_K + 8);
      uint4 v0 = *(const uint4*)(src + C_V), v1 = *(const uint4*)(src + C_V + 8);
      *(uint4*)&Ks[key * 72 + dq] = k0;
      *(uint4*)&Ks[key * 72 + dq + 8] = k1;
#define VTW(e, val) Vt[(dq + 2 * (e)) * 72 + key] = (u16)((val) & 0xffffu); Vt[(dq + 2 * (e) + 1) * 72 + key] = (u16)((val) >> 16);
      VTW(0, v0.x) VTW(1, v0.y) VTW(2, v0.z) VTW(3, v0.w) VTW(4, v1.x) VTW(5, v1.y) VTW(6, v1.z) VTW(7, v1.w)
    } else {
      size_t off = ((size_t)(b * 512 + kbase + key) * 2 + kvh) * 64 + dq;
      const float4* ksrc = (const float4*)(p.cache_k + off);
      const float4* vsrc = (const float4*)(p.cache_v + off);
      float4 k0 = ksrc[0], k1 = ksrc[1], k2 = ksrc[2], k3 = ksrc[3];
      float4 v0 = vsrc[0], v1 = vsrc[1], v2 = vsrc[2], v3 = vsrc[3];
      *(uint4*)&Ks[key * 72 + dq] = make_uint4(pack2(k0.x, k0.y), pack2(k0.z, k0.w), pack2(k1.x, k1.y), pack2(k1.z, k1.w));
      *(uint4*)&Ks[key * 72 + dq + 8] = make_uint4(pack2(k2.x, k2.y), pack2(k2.z, k2.w), pack2(k3.x, k3.y), pack2(k3.z, k3.w));
#define VTF(e, val) Vt[(dq + (e)) * 72 + key] = f2bf(val);
      VTF(0, v0.x) VTF(1, v0.y) VTF(2, v0.z) VTF(3, v0.w) VTF(4, v1.x) VTF(5, v1.y) VTF(6, v1.z) VTF(7, v1.w)
      VTF(8, v2.x) VTF(9, v2.y) VTF(10, v2.z) VTF(11, v2.w) VTF(12, v3.x) VTF(13, v3.y) VTF(14, v3.z) VTF(15, v3.w)
    }
    __syncthreads();
    f32x16 S[2];
#pragma unroll
    for (int mb = 0; mb < 2; ++mb) {
#pragma unroll
      for (int i = 0; i < 16; ++i) S[mb][i] = 0.f;
#pragma unroll
      for (int ks = 0; ks < 4; ++ks) {
        bf16x8 a = *(const bf16x8*)&Ks[(mb * 32 + r) * 72 + ks * 16 + hh * 8];
        S[mb] = mfma32(a, qf[ks], S[mb]);
      }
    }
    float mx = -3.0e38f;
#pragma unroll
    for (int mb = 0; mb < 2; ++mb)
#pragma unroll
      for (int i = 0; i < 16; ++i) {
        float s = S[mb][i] * 0.125f;
        if (masked) {
          int kpos = kbase + mb * 32 + rowmap(i, hh);
          int d = qpos - kpos;
          if (d > 128 || d < -128) s = -1e30f;
        }
        S[mb][i] = s;
        mx = fmaxf(mx, s);
      }
    mx = fmaxf(mx, __shfl_xor(mx, 32));
    const float mnew = fmaxf(m, mx);
    const float alpha = __expf(m - mnew);
    float rs = 0.f;
#pragma unroll
    for (int mb = 0; mb < 2; ++mb)
#pragma unroll
      for (int i = 0; i < 16; ++i) {
        float pv = __expf(S[mb][i] - mnew);
        S[mb][i] = pv;
        rs += pv;
      }
    rs += __shfl_xor(rs, 32);
    l = l * alpha + rs;
    m = mnew;
#pragma unroll
    for (int i = 0; i < 16; ++i) { O0[i] *= alpha; O1[i] *= alpha; }
#pragma unroll
    for (int mb = 0; mb < 2; ++mb)
#pragma unroll
      for (int s = 0; s < 2; ++s) {
        u32x4 pku;
        pku.x = pack2(S[mb][8 * s + 0], S[mb][8 * s + 1]);
        pku.y = pack2(S[mb][8 * s + 2], S[mb][8 * s + 3]);
        pku.z = pack2(S[mb][8 * s + 4], S[mb][8 * s + 5]);
        pku.w = pack2(S[mb][8 * s + 6], S[mb][8 * s + 7]);
        const bf16x8 pkv = __builtin_bit_cast(bf16x8, pku);
        const int kk = mb * 32 + 16 * s + 4 * hh;
        {
          uint2 q0 = *(const uint2*)&Vt[r * 72 + kk];
          uint2 q1 = *(const uint2*)&Vt[r * 72 + kk + 8];
          u32x4 au; au.x = q0.x; au.y = q0.y; au.z = q1.x; au.w = q1.y;
          O0 = mfma32(__builtin_bit_cast(bf16x8, au), pkv, O0);
        }
        {
          uint2 q0 = *(const uint2*)&Vt[(32 + r) * 72 + kk];
          uint2 q1 = *(const uint2*)&Vt[(32 + r) * 72 + kk + 8];
          u32x4 au; au.x = q0.x; au.y = q0.y; au.z = q1.x; au.w = q1.y;
          O1 = mfma32(__builtin_bit_cast(bf16x8, au), pkv, O1);
        }
      }
    __syncthreads();
  }
  const float inv = 1.f / l;
  float* Ow = Os + w * 32 * 68;
#pragma unroll
  for (int i = 0; i < 16; ++i) {
    Ow[r * 68 + rowmap(i, hh)] = O0[i] * inv;
    Ow[r * 68 + 32 + rowmap(i, hh)] = O1[i] * inv;
  }
  __syncthreads();
#pragma unroll
  for (int i = 0; i < 4; ++i) {
    int idx = lane + 64 * i;
    int row = idx >> 3, c8 = (idx & 7) * 8;
    int t = t0 + w * 32 + row;
    float4 o0 = *(const float4*)&Ow[row * 68 + c8];
    float4 o1 = *(const float4*)&Ow[row * 68 + c8 + 4];
    uint4 za = *(const uint4*)(Z + (size_t)t * ZW + C_ZA + h * 64 + c8);
    uint4 yo;
    yo.x = pack2(o0.x * siluf(bflo(za.x)), o0.y * siluf(bfhi(za.x)));
    yo.y = pack2(o0.z * siluf(bflo(za.y)), o0.w * siluf(bfhi(za.y)));
    yo.z = pack2(o1.x * siluf(bflo(za.z)), o1.y * siluf(bfhi(za.z)));
    yo.w = pack2(o1.z * siluf(bflo(za.w)), o1.w * siluf(bfhi(za.w)));
    *(uint4*)(Y + (size_t)t * DM + h * 64 + c8) = yo;
  }
  __syncthreads();
}

__device__ __forceinline__ void gla_gates(const Params& p, int t0, int h, float* part, float (&gcf)[16],
                                          float (&gcb)[16], float& gtf, float& gtb) {
  const int tid = threadIdx.x, dk = tid & 63, tq = tid >> 6;
  const float* LR = (const float*)(p.ws + OFF_LR);
  float wf[16], wb[16];
#pragma unroll
  for (int rr = 0; rr < 16; ++rr) {
    wf[rr] = p.w_gk_f[rr * 256 + h * 64 + dk];
    wb[rr] = p.w_gk_b[rr * 256 + h * 64 + dk];
  }
  const float bf = p.b_gk_f[h * 64 + dk], bb = p.b_gk_b[h * 64 + dk];
#pragma unroll
  for (int j = 0; j < 16; ++j) {
    const float4* lr4 = (const float4*)(LR + (size_t)(t0 + tq * 16 + j) * 32);
    float4 a0 = lr4[0], a1 = lr4[1], a2 = lr4[2], a3 = lr4[3];
    float4 c0 = lr4[4], c1 = lr4[5], c2 = lr4[6], c3 = lr4[7];
    float pf = bf + a0.x * wf[0] + a0.y * wf[1] + a0.z * wf[2] + a0.w * wf[3] + a1.x * wf[4] + a1.y * wf[5] +
               a1.z * wf[6] + a1.w * wf[7] + a2.x * wf[8] + a2.y * wf[9] + a2.z * wf[10] + a2.w * wf[11] +
               a3.x * wf[12] + a3.y * wf[13] + a3.z * wf[14] + a3.w * wf[15];
    float pb = bb + c0.x * wb[0] + c0.y * wb[1] + c0.z * wb[2] + c0.w * wb[3] + c1.x * wb[4] + c1.y * wb[5] +
               c1.z * wb[6] + c1.w * wb[7] + c2.x * wb[8] + c2.y * wb[9] + c2.z * wb[10] + c2.w * wb[11] +
               c3.x * wb[12] + c3.y * wb[13] + c3.z * wb[14] + c3.w * wb[15];
    gcf[j] = logsigf(pf) * 0.0625f;
    gcb[j] = logsigf(pb) * 0.0625f;
  }
#pragma unroll
  for (int j = 1; j < 16; ++j) gcf[j] += gcf[j - 1];
#pragma unroll
  for (int j = 14; j >= 0; --j) gcb[j] += gcb[j + 1];
  part[tq * 64 + dk] = gcf[15];
  part[(4 + tq) * 64 + dk] = gcb[0];
  __syncthreads();
  float offf = 0.f, offb = 0.f;
  gtf = 0.f; gtb = 0.f;
#pragma unroll
  for (int q = 0; q < 4; ++q) {
    float a = part[q * 64 + dk], bq = part[(4 + q) * 64 + dk];
    gtf += a; gtb += bq;
    if (q < tq) offf += a;
    if (q > tq) offb += bq;
  }
#pragma unroll
  for (int j = 0; j < 16; ++j) { gcf[j] += offf; gcb[j] += offb; }
}

__device__ __forceinline__ void stage_vt(const u16* Z, int t0, int h, u16* Vt) {
  const int tid = threadIdx.x;
  const int tok = tid >> 2, dq = (tid & 3) * 32;
  const uint4* src = (const uint4*)(Z + (size_t)(t0 + tok) * ZW + C_VG + h * 128 + dq);
#pragma unroll
  for (int i = 0; i < 4; ++i) {
    uint4 u = src[i];
#define VTG(e, val) Vt[(dq + i * 8 + 2 * (e)) * 72 + tok] = (u16)((val) & 0xffffu); Vt[(dq + i * 8 + 2 * (e) + 1) * 72 + tok] = (u16)((val) >> 16);
    VTG(0, u.x) VTG(1, u.y) VTG(2, u.z) VTG(3, u.w)
  }
}

__device__ void gla_ds_task(const Params& p, int task, unsigned char* smem) {
  const int cgk = task >> 2, h = task & 3, t0 = cgk * 64;
  u16* KeF = (u16*)smem;
  u16* KeB = KeF + 64 * 72;
  u16* Vt = KeB + 64 * 72;
  float* part = (float*)(Vt + 128 * 72);
  const u16* Z = (const u16*)(p.ws + OFF_Z);
  float* DST = p.out;
  float* DEC = (float*)(p.ws + OFF_DEC);
  const int tid = threadIdx.x, lane = tid & 63, w = tid >> 6, r = lane & 31, hh = lane >> 5;
  const int dk = tid & 63, tq = tid >> 6;
  float gcf[16], gcb[16], gtf, gtb;
  gla_gates(p, t0, h, part, gcf, gcb, gtf, gtb);
#pragma unroll
  for (int j = 0; j < 16; ++j) {
    int tok = tq * 16 + j;
    float k = bf2f(Z[(size_t)(t0 + tok) * ZW + C_KG + h * 64 + dk]);
    KeF[dk * 72 + tok] = f2bf(k * __expf(gtf - gcf[j]));
    KeB[dk * 72 + tok] = f2bf(k * __expf(gtb - gcb[j]));
  }
  if (tq == 0) {
    DEC[(size_t)(task * 2 + 0) * 64 + dk] = __expf(gtf);
    DEC[(size_t)(task * 2 + 1) * 64 + dk] = __expf(gtb);
  }
  stage_vt(Z, t0, h, Vt);
  __syncthreads();
#pragma unroll
  for (int dir = 0; dir < 2; ++dir) {
    const u16* Ke = dir ? KeB : KeF;
#pragma unroll
    for (int nb = 0; nb < 2; ++nb) {
      f32x16 acc;
#pragma unroll
      for (int i = 0; i < 16; ++i) acc[i] = 0.f;
#pragma unroll
      for (int ks = 0; ks < 4; ++ks) {
        bf16x8 a = *(const bf16x8*)&Vt[(w * 32 + r) * 72 + ks * 16 + hh * 8];
        bf16x8 bq = *(const bf16x8*)&Ke[(nb * 32 + r) * 72 + ks * 16 + hh * 8];
        acc = mfma32(a, bq, acc);
      }
      float* dst = DST + ((size_t)(task * 2 + dir) * 128) * 64 + nb * 32 + r;
#pragma unroll
      for (int i = 0; i < 16; ++i) dst[(size_t)(w * 32 + rowmap(i, hh)) * 64] = acc[i];
    }
  }
  __syncthreads();
}

__device__ void gla_scan_task(const Params& p, int task) {
  const float* DST = p.out;
  const float* DEC = (const float*)(p.ws + OFF_DEC);
  u16* SPT = (u16*)(p.ws + OFF_SPT);
  const int tid = threadIdx.x;
  int b, h, dir, part, n, cgbase;
  bool sample;
  if (task < 256) { int chain = task >> 3; part = task & 7; b = chain >> 3; h = (chain >> 1) & 3; dir = chain & 1; n = 64; cgbase = 128 + b * 64; sample = true; }
  else { int tt = task - 256; int chain = tt >> 3; part = tt & 7; b = chain >> 3; h = (chain >> 1) & 3; dir = chain & 1; n = 4; cgbase = b * 4; sample = false; }
  const int e4 = part * 256 + tid;
  const int dv = e4 >> 4, dk4 = (e4 & 15) * 4;
  float4 s = make_float4(0.f, 0.f, 0.f, 0.f);
  const size_t sbase = ((size_t)((b * 2 + dir) * 4 + h)) * 8192;
  if (sample) {
    const float* sg = p.state_gla + sbase;
    s.x = sg[(dk4 + 0) * 128 + dv]; s.y = sg[(dk4 + 1) * 128 + dv];
    s.z = sg[(dk4 + 2) * 128 + dv]; s.w = sg[(dk4 + 3) * 128 + dv];
  }
#pragma unroll 4
  for (int i = 0; i < n; ++i) {
    int c = dir ? (n - 1 - i) : i;
    size_t idx = (size_t)((cgbase + c) * 4 + h) * 2 + dir;
    float4 d = *(const float4*)(DST + idx * 8192 + (size_t)e4 * 4);
    float4 dc = *(const float4*)(DEC + idx * 64 + dk4);
    *(uint2*)(SPT + idx * 8192 + (size_t)e4 * 4) = make_uint2(pack2(s.x, s.y), pack2(s.z, s.w));
    s.x = dc.x * s.x + d.x; s.y = dc.y * s.y + d.y; s.z = dc.z * s.z + d.z; s.w = dc.w * s.w + d.w;
  }
  if (!sample) {
    float* ns = p.out + OUT_NS + sbase;
    ns[(dk4 + 0) * 128 + dv] = s.x; ns[(dk4 + 1) * 128 + dv] = s.y;
    ns[(dk4 + 2) * 128 + dv] = s.z; ns[(dk4 + 3) * 128 + dv] = s.w;
  }
}

__device__ void gla_out_task(const Params& p, int task, unsigned char* smem) {
  const int cgk = task >> 2, h = task & 3, t0 = cgk * 64;
  u16* QdF = (u16*)smem;
  u16* QdB = QdF + 64 * 72;
  u16* KiF = QdB + 64 * 72;
  u16* KiB = KiF + 64 * 72;
  u16* Vt = KiB + 64 * 72;
  float* part = (float*)(Vt + 128 * 72);
  float* ssq = part + 512;
  float* Os = (float*)smem;
  const u16* Z = (const u16*)(p.ws + OFF_Z);
  const u16* SPT = (const u16*)(p.ws + OFF_SPT);
  u16* Y = (u16*)(p.ws + OFF_HY);
  const int tid = threadIdx.x, lane = tid & 63, w = tid >> 6, r = lane & 31, hh = lane >> 5;
  const int dk = tid & 63, tq = tid >> 6;
  {
    float gcf[16], gcb[16], gtf, gtb;
    gla_gates(p, t0, h, part, gcf, gcb, gtf, gtb);
#pragma unroll
    for (int j = 0; j < 16; ++j) {
      int tok = tq * 16 + j;
      const u16* zr = Z + (size_t)(t0 + tok) * ZW + h * 64 + dk;
      float q = bf2f(zr[C_QG]) * 0.125f, k = bf2f(zr[C_KG]);
      float ef = __expf(gcf[j]), eb = __expf(gcb[j]);
      QdF[tok * 72 + dk] = f2bf(q * ef);
      QdB[tok * 72 + dk] = f2bf(q * eb);
      KiF[tok * 72 + dk] = f2bf(k / ef);
      KiB[tok * 72 + dk] = f2bf(k / eb);
    }
  }
  stage_vt(Z, t0, h, Vt);
  __syncthreads();
  const int ib = w & 1, dh = w >> 1;
  bf16x8 qF[4], qB[4];
#pragma unroll
  for (int ks = 0; ks < 4; ++ks) {
    qF[ks] = *(const bf16x8*)&QdF[(ib * 32 + r) * 72 + ks * 16 + hh * 8];
    qB[ks] = *(const bf16x8*)&QdB[(ib * 32 + r) * 72 + ks * 16 + hh * 8];
  }
  f32x16 comb[2];
  const int ii = ib * 32 + r;
#pragma unroll
  for (int mb = 0; mb < 2; ++mb) {
    f32x16 xf, xb;
#pragma unroll
    for (int i = 0; i < 16; ++i) { xf[i] = 0.f; xb[i] = 0.f; }
#pragma unroll
    for (int ks = 0; ks < 4; ++ks) {
      bf16x8 a = *(const bf16x8*)&KiF[(mb * 32 + r) * 72 + ks * 16 + hh * 8];
      xf = mfma32(a, qF[ks], xf);
      bf16x8 a2 = *(const bf16x8*)&KiB[(mb * 32 + r) * 72 + ks * 16 + hh * 8];
      xb = mfma32(a2, qB[ks], xb);
    }
#pragma unroll
    for (int i = 0; i < 16; ++i) {
      int jj = mb * 32 + rowmap(i, hh);
      comb[mb][i] = ((ii >= jj) ? xf[i] : 0.f) + ((ii <= jj) ? xb[i] : 0.f);
    }
  }
  f32x16 o[2];
#pragma unroll
  for (int db = 0; db < 2; ++db) {
#pragma unroll
    for (int i = 0; i < 16; ++i) o[db][i] = 0.f;
    const int dvrow = dh * 64 + db * 32 + r;
#pragma unroll
    for (int mb = 0; mb < 2; ++mb)
#pragma unroll
      for (int s = 0; s < 2; ++s) {
        u32x4 pku;
        pku.x = pack2(comb[mb][8 * s + 0], comb[mb][8 * s + 1]);
        pku.y = pack2(comb[mb][8 * s + 2], comb[mb][8 * s + 3]);
        pku.z = pack2(comb[mb][8 * s + 4], comb[mb][8 * s + 5]);
        pku.w = pack2(comb[mb][8 * s + 6], comb[mb][8 * s + 7]);
        const int kk = mb * 32 + 16 * s + 4 * hh;
        uint2 q0 = *(const uint2*)&Vt[dvrow * 72 + kk];
        uint2 q1 = *(const uint2*)&Vt[dvrow * 72 + kk + 8];
        u32x4 au; au.x = q0.x; au.y = q0.y; au.z = q1.x; au.w = q1.y;
        o[db] = mfma32(__builtin_bit_cast(bf16x8, au), __builtin_bit_cast(bf16x8, pku), o[db]);
      }
    const u16* sf = SPT + ((size_t)(task * 2 + 0) * 128 + dvrow) * 64 + hh * 8;
    const u16* sb = SPT + ((size_t)(task * 2 + 1) * 128 + dvrow) * 64 + hh * 8;
#pragma unroll
    for (int ks = 0; ks < 4; ++ks) {
      bf16x8 a = *(const bf16x8*)(sf + ks * 16);
      o[db] = mfma32(a, qF[ks], o[db]);
      bf16x8 a2 = *(const bf16x8*)(sb + ks * 16);
      o[db] = mfma32(a2, qB[ks], o[db]);
    }
  }
  float ss = 0.f;
#pragma unroll
  for (int db = 0; db < 2; ++db)
#pragma unroll
    for (int i = 0; i < 16; ++i) ss += o[db][i] * o[db][i];
  ss += __shfl_xor(ss, 32);
  if (hh == 0) ssq[dh * 64 + ii] = ss;
  __syncthreads();
  const float rstd = rsqrtf((ssq[ii] + ssq[64 + ii]) * (1.f / 128.f) + EPSV);
#pragma unroll
  for (int db = 0; db < 2; ++db)
#pragma unroll
    for (int i = 0; i < 16; ++i) Os[ii * 132 + dh * 64 + db * 32 + rowmap(i, hh)] = o[db][i] * rstd;
  __syncthreads();
#pragma unroll
  for (int i = 0; i < 4; ++i) {
    int idx = tid + 256 * i;
    int tok = idx >> 4, c8 = (idx & 15) * 8;
    float4 o0 = *(const float4*)&Os[tok * 132 + c8];
    float4 o1 = *(const float4*)&Os[tok * 132 + c8 + 4];
    float4 g0 = *(const float4*)(p.gla_norm_g + c8);
    float4 g1 = *(const float4*)(p.gla_norm_g + c8 + 4);
    uint4 zg = *(const uint4*)(Z + (size_t)(t0 + tok) * ZW + C_ZG + h * 128 + c8);
    uint4 yo;
    yo.x = pack2(o0.x * g0.x * siluf(bflo(zg.x)), o0.y * g0.y * siluf(bfhi(zg.x)));
    yo.y = pack2(o0.z * g0.z * siluf(bflo(zg.y)), o0.w * g0.w * siluf(bfhi(zg.y)));
    yo.z = pack2(o1.x * g1.x * siluf(bflo(zg.z)), o1.y * g1.y * siluf(bfhi(zg.z)));
    yo.w = pack2(o1.z * g1.z * siluf(bflo(zg.w)), o1.w * g1.w * siluf(bfhi(zg.w)));
    *(uint4*)(Y + (size_t)(t0 + tok) * DM + 512 + h * 128 + c8) = yo;
  }
  __syncthreads();
}

__device__ void final_rows(const Params& p) {
  const int lane = threadIdx.x & 63, w = threadIdx.x >> 6;
  for (int row = blockIdx.x * 4 + w; row < T_TOK; row += gridDim.x * 4) {
    float* x = p.out + OUT_Y + (size_t)row * DM;
    float4 v[4];
    float ss = 0.f;
#pragma unroll
    for (int i = 0; i < 4; ++i) {
      v[i] = *(const float4*)(x + i * 256 + lane * 4);
      ss += v[i].x * v[i].x + v[i].y * v[i].y + v[i].z * v[i].z + v[i].w * v[i].w;
    }
#pragma unroll
    for (int o = 32; o >= 1; o >>= 1) ss += __shfl_xor(ss, o);
    const float rstd = rsqrtf(ss * (1.f / 1024.f) + EPSV);
#pragma unroll
    for (int i = 0; i < 4; ++i) {
      int col = i * 256 + lane * 4;
      float4 g = *(const float4*)(p.final_norm_g + col);
      float4 o4 = make_float4(v[i].x * rstd * g.x, v[i].y * rstd * g.y, v[i].z * rstd * g.z, v[i].w * rstd * g.w);
      *(float4*)(x + col) = o4;
    }
  }
}

__global__ void __launch_bounds__(256, 2) mega(Params p) {
  __shared__ __attribute__((aligned(16))) unsigned char smem[LDS_BYTES];
  cg::grid_group grid = cg::this_grid();
  if (p.ws == nullptr) grid.sync();
  if (threadIdx.x == 0) *(uint4*)(smem + LDS_BYTES - 16) = make_uint4(0u, 0u, 0u, 0u);
  __syncthreads();
  const XcdBarrier xb = xcd_barrier_post((unsigned*)(p.ws + OFF_BAR), (volatile LAS unsigned*)(smem + LDS_BYTES - 16));
  const int nb = gridDim.x;
  for (int t = blockIdx.x; t < 192 + 736 + 256 + 1; t += nb) {
    if (t < 192) p0_adaln(p, t, smem);
    else if (t < 192 + 736) { int q = t - 192; p0_transpose(p.w_in, ZW, (u16*)(p.ws + OFF_WINT), q / 46, q % 46, smem); }
    else if (t < 192 + 736 + 256) { int q = t - 928; p0_transpose(p.w_out, 1024, (u16*)(p.ws + OFF_WOUTT), q >> 4, q & 15, smem); }
    else p0_rope(p);
  }
  xcd_barrier(xb);
  p1_rows(p);
  xcd_barrier(xb);
  for (int t = blockIdx.x; t < 192 * 23; t += nb)
    gemm_tile<1>(p, (const u16*)(p.ws + OFF_HY), (const u16*)(p.ws + OFF_WINT), t / 23, t % 23, smem);
  xcd_barrier(xb);
  for (int t = blockIdx.x; t < 1536 + 1536; t += nb) {
    if (t < 1536) gla_ds_task(p, t, smem);
    else attn_item(p, t - 1536, smem);
  }
  xcd_barrier(xb);
  for (int t = blockIdx.x; t < 2304; t += nb) gla_scan_task(p, t);
  xcd_barrier(xb);
  for (int t = blockIdx.x; t < 1536; t += nb) gla_out_task(p, t, smem);
  xcd_barrier(xb);
  for (int t = blockIdx.x; t < 192 * 8; t += nb)
    gemm_tile<2>(p, (const u16*)(p.ws + OFF_HY), (const u16*)(p.ws + OFF_WOUTT), t >> 3, t & 7, smem);
  xcd_barrier(xb);
  final_rows(p);
}

extern "C" void kernel_launch(void* const* d_in, const int* in_sizes, int n_in, void* d_out, int out_size,
                              void* d_ws, size_t ws_size, hipStream_t stream) {
  static int grid_blocks = 0;
  if (!grid_blocks) {
    int dev = 0, cus = 0, per_cu = 0;
    hipGetDevice(&dev);
    hipDeviceGetAttribute(&cus, hipDeviceAttributeMultiprocessorCount, dev);
    hipOccupancyMaxActiveBlocksPerMultiprocessor(&per_cu, mega, 256, 0);
    if (per_cu < 1) per_cu = 1;
    if (per_cu > 2) per_cu = 2;
    grid_blocks = cus * per_cu;
  }
  Params p{};
  const float** pp = (const float**)&p;
  for (int i = 0; i < 19; ++i) pp[i] = (const float*)d_in[i];
  p.out = (float*)d_out;
  p.ws = (unsigned char*)d_ws;
  hipMemsetAsync((char*)d_ws + OFF_BAR, 0, XCD_BAR_WORDS * 4, stream);
  void* args[] = {&p};
  hipError_t e = hipLaunchCooperativeKernel((void*)mega, dim3(grid_blocks), dim3(256), args, 0, stream);
  if (e != hipSuccess) fprintf(stderr, "cooperative launch failed: %s (grid %d)\n", hipGetErrorString(e), grid_blocks);
}
```

```cpp
#include <hip/hip_runtime.h>
#include <hip/hip_cooperative_groups.h>
#include <cstdio>
namespace cg = cooperative_groups;

typedef unsigned short u16;
using bf16x8 = __attribute__((ext_vector_type(8))) short;
using f32x4  = __attribute__((ext_vector_type(4))) float;
using f32x16 = __attribute__((ext_vector_type(16))) float;
using u32x4 = __attribute__((ext_vector_type(4))) unsigned;

#define T_TOK   24576
#define NP_TOK  8192
#define DM      1024
#define ZW      2848
#define ZWP     3072
#define EPSV    1e-6f

#define C_Q   0
#define C_K   512
#define C_V   640
#define C_ZA  768
#define C_QG  1280
#define C_KG  1536
#define C_VG  1792
#define C_LR  2304
#define C_ZG  2336

#define OFF_MOD   0ull
#define OFF_ROPE  65536ull
#define OFF_BAR   81920ull
#define OFF_DEC   131072ull
#define OFF_LR    1048576ull
#define OFF_WINT  4194304ull
#define OFF_WOUTT 10485760ull
#define OFF_HY    12582912ull
#define OFF_Z     62914560ull
#define OFF_SPT   202899456ull
#define OFF_VTG   253231104ull
#define OFF_KC    260046848ull
#define TTOT      26624

#define OUT_Y     0
#define OUT_NK    25165824
#define OUT_NV    26214400
#define OUT_NS    27262976

#define LDS_HALF  59392
#define LDS_GEMM  131072
#define LDS_TOTAL (LDS_GEMM + 16)

struct Params {
  const float *xp, *xs, *c, *cache_k, *cache_v, *state_gla, *c_ctx, *w_mod, *b_mod, *norm_g, *w_in,
              *w_gk_f, *b_gk_f, *w_gk_b, *b_gk_b, *sink, *gla_norm_g, *w_out, *final_norm_g;
  float* out;
  unsigned char* ws;
};

typedef __bf16 bf16v2_t __attribute__((ext_vector_type(2)));
typedef float f32v2_t __attribute__((ext_vector_type(2)));
__device__ __forceinline__ unsigned cvtpk(float lo, float hi) { f32v2_t f = {lo, hi}; bf16v2_t b = __builtin_convertvector(f, bf16v2_t); return __builtin_bit_cast(unsigned, b); }
__device__ __forceinline__ u16 f2bf(float f) { return (u16)(cvtpk(f, f) & 0xffffu); }
__device__ __forceinline__ float bf2f(u16 h) { return __uint_as_float(((unsigned)h) << 16); }
__device__ __forceinline__ unsigned pack2(float a, float b) { return cvtpk(a, b); }
__device__ __forceinline__ float bflo(unsigned u) { return __uint_as_float(u << 16); }
__device__ __forceinline__ float bfhi(unsigned u) { return __uint_as_float(u & 0xffff0000u); }
__device__ __forceinline__ float siluf(float x) { return x / (1.f + __expf(-x)); }
__device__ __forceinline__ float logsigf(float x) { return fminf(x, 0.f) - __logf(1.f + __expf(-fabsf(x))); }
using u32x2 = __attribute__((ext_vector_type(2))) unsigned;
__device__ __forceinline__ uint4 ldnt16(const void* p) { const u32x4 v = __builtin_nontemporal_load((const u32x4*)p); return make_uint4(v.x, v.y, v.z, v.w); }
__device__ __forceinline__ uint2 ldnt8(const void* p) { const u32x2 v = __builtin_nontemporal_load((const u32x2*)p); return make_uint2(v.x, v.y); }
__device__ __forceinline__ float4 ldnt16f(const float* p) { const f32x4 v = __builtin_nontemporal_load((const f32x4*)p); return make_float4(v[0], v[1], v[2], v[3]); }
__device__ __forceinline__ int opq(int v) { asm volatile("" : "+v"(v)); return v; }
__device__ __forceinline__ int rowmap(int reg, int hh) { return (reg & 3) + 8 * (reg >> 2) + 4 * hh; }

__device__ __forceinline__ f32x16 mfma32(bf16x8 a, bf16x8 b, f32x16 c) {
  return __builtin_amdgcn_mfma_f32_32x32x16_bf16(a, b, c, 0, 0, 0);
}
__device__ __forceinline__ f32x4 mfma16(bf16x8 a, bf16x8 b, f32x4 c) {
  return __builtin_amdgcn_mfma_f32_16x16x32_bf16(a, b, c, 0, 0, 0);
}
__device__ __forceinline__ const float* xrow_ptr(const Params& p, int t) {
  return (t < NP_TOK) ? (p.xp + (size_t)t * DM) : (p.xs + (size_t)(t - NP_TOK) * DM);
}
__device__ __forceinline__ int mod_idx(int t) { return (t < NP_TOK) ? 0 : 1 + ((t - NP_TOK) >> 12); }

__device__ const double kFreq[16] = {
  1.0, 0.5623413251903491, 0.31622776601683794, 0.1778279410038923, 0.1, 0.05623413251903491,
  0.03162277660168379, 0.01778279410038923, 0.01, 0.005623413251903491, 0.0031622776601683794,
  0.0017782794100389228, 0.001, 0.0005623413251903491, 0.00031622776601683794, 0.00017782794100389227};

#define XB_TMO      128
#define XB_XCNT(j)  (256  + 64 * (j))
#define XB_XSUB(j)  (1280 + 64 * (j))
#define XB_XGEN(j)  (2304 + 64 * (j))
#define XB_TOP      3328
#define XB_TOPGEN   3392
#define XCD_BAR_WORDS 3456
#define XB_SPIN_CAP (1u << 18)
#define LAS __attribute__((address_space(3)))

__device__ __forceinline__ unsigned xb_ld(unsigned* p)              { return __hip_atomic_load(p, __ATOMIC_RELAXED, __HIP_MEMORY_SCOPE_AGENT); }
__device__ __forceinline__ unsigned xb_add(unsigned* p, unsigned v) { return __hip_atomic_fetch_add(p, v, __ATOMIC_RELAXED, __HIP_MEMORY_SCOPE_AGENT); }
__device__ __forceinline__ unsigned xb_xcc_id() { return (unsigned)__builtin_amdgcn_s_getreg((3 << 11) | 20) & 0xFu; }
#define XB_SPIN(cond, bar) do { unsigned _sp = 0; while (cond) { __builtin_amdgcn_s_sleep(1); \
    if ((++_sp & 255u) == 0u) { if (xb_ld(&(bar)[XB_TMO])) break; if (_sp > XB_SPIN_CAP) { atomicAdd(&(bar)[XB_TMO], 1u); break; } } } } while (0)

struct XcdBarrier {
    unsigned* bar; unsigned x;
    volatile LAS unsigned* st;
};

__device__ __forceinline__ XcdBarrier xcd_barrier_post(unsigned* bar, volatile LAS unsigned* st) {
    XcdBarrier b; b.bar = bar; b.x = xb_xcc_id(); b.st = st;
    if (threadIdx.x == 0) (void)xb_add(&bar[XB_XCNT(b.x)], 1u);
    return b;
}
__device__ __forceinline__ void xcd_barrier_complete(unsigned* bar, unsigned x, unsigned& nloc, unsigned& nx) {
    const unsigned G = gridDim.x * gridDim.y * gridDim.z;
    unsigned sum, cnt, mine, sp = 0u;
    for (;;) {
        sum = 0u; cnt = 0u; mine = 0u;
#pragma unroll
        for (unsigned j = 0; j < 16; ++j) { const unsigned c = xb_ld(&bar[XB_XCNT(j)]); sum += c; cnt += (c > 0u) ? 1u : 0u; mine = (j == x) ? c : mine; }
        if (sum == G) break;
        __builtin_amdgcn_s_sleep(1);
        if ((++sp & 255u) == 0u) { if (xb_ld(&bar[XB_TMO])) break; if (sp > XB_SPIN_CAP) { atomicAdd(&bar[XB_TMO], 1u); break; } }
    }
    nloc = mine > 0u ? mine : 1u; nx = cnt > 0u ? cnt : 1u;
}

__device__ __forceinline__ void xcd_barrier(const XcdBarrier& b) {
    asm volatile("s_waitcnt vmcnt(0)" ::: "memory");
    __syncthreads();
    if (threadIdx.x == 0) {
        unsigned* bar = b.bar;
        __builtin_amdgcn_s_waitcnt(0);
        unsigned nloc = b.st[0], nx = b.st[1];
        if (nloc == 0u) { xcd_barrier_complete(bar, b.x, nloc, nx); b.st[0] = nloc; b.st[1] = nx; }
        const unsigned old = xb_add(&bar[XB_XSUB(b.x)], 1u);
        const unsigned gen = old / nloc;
        if (old + 1u == (gen + 1u) * nloc) {
            __builtin_amdgcn_fence(__ATOMIC_RELEASE, "agent");
            asm volatile("s_waitcnt vmcnt(0)" ::: "memory");
            const unsigned og = xb_add(&bar[XB_TOP], 1u);
            const unsigned tg = og / nx;
            if (og + 1u == (tg + 1u) * nx) xb_add(&bar[XB_TOPGEN], 1u);
            else XB_SPIN(xb_ld(&bar[XB_TOPGEN]) == tg, bar);
            __builtin_amdgcn_fence(__ATOMIC_ACQUIRE, "agent");
            xb_add(&bar[XB_XGEN(b.x)], 1u);
            asm volatile("s_waitcnt vmcnt(0)" ::: "memory");
        } else {
            XB_SPIN(xb_ld(&bar[XB_XGEN(b.x)]) == gen, bar);
            __builtin_amdgcn_fence(__ATOMIC_ACQUIRE, "agent");
            asm volatile("s_waitcnt vmcnt(0)" ::: "memory");
        }
    }
    __syncthreads();
}


__device__ void p0_adaln(const Params& p, int task, unsigned char* smem, const int tid) {
  float* sc  = (float*)smem;
  float* red = sc + 5120;
  float* MOD = (float*)(p.ws + OFF_MOD);
  const int rg = tid >> 1, qd = tid & 1;
  const int c0 = task * 8 + qd * 4;
  float4 wv[8];
#pragma unroll
  for (int it = 0; it < 8; ++it) wv[it] = ldnt16f(p.w_mod + (size_t)(it * 128 + rg) * 3072 + c0);
  for (int e = tid; e < 5120; e += 256) {
    int i = e >> 10, k = e & 1023;
    float v = (i == 0) ? p.c_ctx[k] : p.c[(i - 1) * 1024 + k];
    sc[e] = siluf(v);
  }
  __syncthreads();
  float acc[5][4];
#pragma unroll
  for (int i = 0; i < 5; ++i)
#pragma unroll
    for (int j = 0; j < 4; ++j) acc[i][j] = 0.f;
#pragma unroll
  for (int it = 0; it < 8; ++it) {
    const int row = it * 128 + rg;
#pragma unroll
    for (int i = 0; i < 5; ++i) {
      const float sv = sc[i * 1024 + row];
      acc[i][0] += sv * wv[it].x; acc[i][1] += sv * wv[it].y; acc[i][2] += sv * wv[it].z; acc[i][3] += sv * wv[it].w;
    }
  }
#pragma unroll
  for (int i = 0; i < 5; ++i)
#pragma unroll
    for (int j = 0; j < 4; ++j) red[rg * 40 + i * 8 + qd * 4 + j] = acc[i][j];
  __syncthreads();
  if (tid < 40) {
    const int i = tid >> 3, cc = tid & 7;
    float sum = 0.f;
    for (int r2 = 0; r2 < 128; ++r2) sum += red[r2 * 40 + tid];
    MOD[i * 3072 + task * 8 + cc] = sum + p.b_mod[task * 8 + cc];
  }
  __syncthreads();
}

__device__ void p0_transpose(const float* W, int N, u16* WT, int kt, int nt, unsigned char* smem, const int tid) {
  float* tile = (float*)smem;
  const int r = tid >> 4, c4 = (tid & 15) * 4;
  const int k0 = kt * 64, n0 = nt * 64;
#pragma unroll
  for (int it = 0; it < 4; ++it) {
    int row = r + 16 * it;
    float4 v = make_float4(0.f, 0.f, 0.f, 0.f);
    if (n0 + c4 < N) v = ldnt16f(W + (size_t)(k0 + row) * N + n0 + c4);
    tile[row * 65 + c4 + 0] = v.x; tile[row * 65 + c4 + 1] = v.y;
    tile[row * 65 + c4 + 2] = v.z; tile[row * 65 + c4 + 3] = v.w;
  }
  __syncthreads();
  const int n = tid >> 2, kq = (tid & 3) * 16;
  unsigned u[8];
#pragma unroll
  for (int j = 0; j < 8; ++j) u[j] = pack2(tile[(kq + 2 * j) * 65 + n], tile[(kq + 2 * j + 1) * 65 + n]);
  uint4* dst = (uint4*)(WT + (size_t)(n0 + n) * 1024 + k0 + kq);
  dst[0] = make_uint4(u[0], u[1], u[2], u[3]);
  dst[1] = make_uint4(u[4], u[5], u[6], u[7]);
  __syncthreads();
}

__device__ void p0_rope(const Params& p, const int tid) {
  float* ROPE = (float*)(p.ws + OFF_ROPE);
  if (tid < 16) {
    double f = kFreq[tid];
    double x2 = f * f, s = 1.0, c = 1.0;
    for (int n = 10; n >= 1; --n) {
      s = 1.0 - x2 / (double)((2 * n) * (2 * n + 1)) * s;
      c = 1.0 - x2 / (double)((2 * n - 1) * (2 * n)) * c;
    }
    s *= f;
    double cc = 1.0, ss = 0.0;
    for (int pos = 0; pos < 64; ++pos) {
      ROPE[pos * 16 + tid] = (float)cc;
      ROPE[1024 + pos * 16 + tid] = (float)ss;
      double nc = cc * c - ss * s, ns = ss * c + cc * s;
      cc = nc; ss = ns;
    }
  }
}

__device__ void p1_rows(const Params& p) {
  const float* MOD = (const float*)(p.ws + OFF_MOD);
  u16* H = (u16*)(p.ws + OFF_HY);
  const int thr = opq(threadIdx.x);
  const int lane = thr & 63, w = thr >> 6;
  float4 g[4];
#pragma unroll
  for (int i = 0; i < 4; ++i) g[i] = *(const float4*)(p.norm_g + i * 256 + lane * 4);
  const int stride = gridDim.x * 8;
  for (int row = blockIdx.x * 8 + w; row < T_TOK; row += 2 * stride) {
    const int row1 = row + stride;
    const bool has1 = row1 < T_TOK;
    const float* x0 = xrow_ptr(p, row);
    const float* x1 = xrow_ptr(p, has1 ? row1 : row);
    const float* md0 = MOD + mod_idx(row) * 3072;
    const float* md1 = MOD + mod_idx(has1 ? row1 : row) * 3072;
    float4 v0[4], v1[4], sh0[4], sc0[4], sh1[4], sc1[4];
#pragma unroll
    for (int i = 0; i < 4; ++i) {
      const f32x4 a = __builtin_nontemporal_load((const f32x4*)(x0 + i * 256 + lane * 4)), b2 = __builtin_nontemporal_load((const f32x4*)(x1 + i * 256 + lane * 4));
      v0[i] = make_float4(a[0], a[1], a[2], a[3]); v1[i] = make_float4(b2[0], b2[1], b2[2], b2[3]);
    }
#pragma unroll
    for (int i = 0; i < 4; ++i) {
      sh0[i] = *(const float4*)(md0 + i * 256 + lane * 4); sc0[i] = *(const float4*)(md0 + 1024 + i * 256 + lane * 4);
      sh1[i] = *(const float4*)(md1 + i * 256 + lane * 4); sc1[i] = *(const float4*)(md1 + 1024 + i * 256 + lane * 4);
    }
    float ss0 = 0.f, ss1 = 0.f;
#pragma unroll
    for (int i = 0; i < 4; ++i) {
      ss0 += v0[i].x * v0[i].x + v0[i].y * v0[i].y + v0[i].z * v0[i].z + v0[i].w * v0[i].w;
      ss1 += v1[i].x * v1[i].x + v1[i].y * v1[i].y + v1[i].z * v1[i].z + v1[i].w * v1[i].w;
    }
#pragma unroll
    for (int o = 32; o >= 1; o >>= 1) { ss0 += __shfl_xor(ss0, o); ss1 += __shfl_xor(ss1, o); }
    const float r0 = rsqrtf(ss0 * (1.f / 1024.f) + EPSV), r1 = rsqrtf(ss1 * (1.f / 1024.f) + EPSV);
#pragma unroll
    for (int i = 0; i < 4; ++i) {
      const int col = i * 256 + lane * 4;
      uint2 o2 = make_uint2(pack2(v0[i].x * r0 * g[i].x * (1.f + sc0[i].x) + sh0[i].x, v0[i].y * r0 * g[i].y * (1.f + sc0[i].y) + sh0[i].y),
                            pack2(v0[i].z * r0 * g[i].z * (1.f + sc0[i].z) + sh0[i].z, v0[i].w * r0 * g[i].w * (1.f + sc0[i].w) + sh0[i].w));
      *(uint2*)(H + (size_t)row * DM + col) = o2;
      if (has1) {
        uint2 o3 = make_uint2(pack2(v1[i].x * r1 * g[i].x * (1.f + sc1[i].x) + sh1[i].x, v1[i].y * r1 * g[i].y * (1.f + sc1[i].y) + sh1[i].y),
                              pack2(v1[i].z * r1 * g[i].z * (1.f + sc1[i].z) + sh1[i].z, v1[i].w * r1 * g[i].w * (1.f + sc1[i].w) + sh1[i].w));
        *(uint2*)(H + (size_t)row1 * DM + col) = o3;
      }
    }
  }
}

namespace pg8 {
#define PG8_LAS __attribute__((address_space(3)))
typedef unsigned short bf16_t;
typedef short bf16x8 __attribute__((ext_vector_type(8)));
typedef float f32x4 __attribute__((ext_vector_type(4)));
typedef unsigned u32x4 __attribute__((ext_vector_type(4)));
constexpr int BM = 256, BK = 64, HALF = 128, HTB = HALF * BK * 2  , STAGE_BYTES = 8 * HTB, NXCD = 8, WGM = 8;

__host__ __device__ __forceinline__ int lds_byte(int r, int c) { const int st = (r >> 4) * 2 + (c >> 5), rr = r & 15, cc = c & 31, ob = rr * 64 + cc * 2; return st * 1024 + (ob ^ (((ob >> 9) & 1) << 5)); }
__host__ __device__ __forceinline__ void stage_rc(int b, int& R, int& C) { const int st = b / 1024, sb = b % 1024, swz = sb ^ (((sb >> 9) & 1) << 5); R = (st >> 1) * 16 + swz / 64; C = (st & 1) * 32 + (swz % 64) / 2; }
__host__ __device__ __forceinline__ int perm32(int rho) { const int n = rho >> 4, i = rho & 15; return 8 * (i >> 2) + 4 * n + (i & 3); }

struct Unit { int pm, pn; };
struct Gemm { const bf16_t* A; const bf16_t* Bt; int M, N, K; };

struct StaticOrder {
    int nM, nN, nwg, G, c;
    __host__ __device__ void init(int M, int N, int G_, int c_) { nM = M / BM; nN = N / BM; nwg = nM * nN; G = G_; c = c_; }
    __host__ __device__ bool next(int i, Unit& u) const {
        const long L = (long)i * G + c; if (L >= nwg) return false;
        int wgid = (int)L; { const int q = nwg / NXCD, r = nwg % NXCD, xcd = wgid % NXCD, off = wgid / NXCD; wgid = (xcd < r ? xcd * (q + 1) : r * (q + 1) + (xcd - r) * q) + off; }
        const int nig = WGM * nN, gid = wgid / nig, fm = gid * WGM, gsz = (nM - fm) < WGM ? (nM - fm) : WGM;
        u.pm = fm + ((wgid % nig) % gsz); u.pn = (wgid % nig) / gsz; return true;
    }
    __device__ __forceinline__ void a_ready(const Unit&) const {}
    __device__ __forceinline__ void done(const Unit&) const {}
};
__device__ __forceinline__ unsigned cvt_pk_bf16(float lo, float hi) { unsigned r; asm volatile("v_cvt_pk_bf16_f32 %0, %1, %2" : "=v"(r) : "v"(lo), "v"(hi)); return r; }
template <class Epi, class Sched, bool STAMP = false>
__device__ __forceinline__ void gemm_phase(PG8_LAS unsigned char* lds, const Gemm g, const Sched& S, const Epi& E, unsigned long long* stamps) {
    int tid_ = threadIdx.x; asm volatile("" : "+v"(tid_));
    const int tid = tid_, wid = __builtin_amdgcn_readfirstlane(tid >> 6), lane = tid & 63, wr = wid >> 2, wc = wid & 3, fr = lane & 15, fq = lane >> 4;
    const int K = g.K, nt = K / BK;
    int ts_lo = 0, ts_hi = 0, nts = 0; const unsigned long long rt_entry = STAMP ? (unsigned long long)wall_clock64() : 0ull;
#define PG8_STAMP() do { if (STAMP && wid == 0 && nts < 64) { const unsigned long long _c = (unsigned long long)clock64(); \
        ts_lo = (lane == nts) ? (int)(unsigned)_c : ts_lo; ts_hi = (lane == nts) ? (int)(unsigned)(_c >> 32) : ts_hi; ++nts; } } while (0)
    PG8_STAMP();
    unsigned voffA[2], voffB[2];
#pragma unroll
    for (int i = 0; i < 2; ++i) { int R, C; stage_rc(tid * 16 + i * 8192, R, C); const int Rb = Epi::PERM ? ((R & ~31) + perm32(R & 31)) : R;
        voffA[i] = (unsigned)(R * K + C) * 2u; voffB[i] = (unsigned)(Rb * K + C) * 2u; }
    const size_t kstep = (size_t)(BK * 2);
    const size_t hstep = (size_t)HALF * K * 2;
    const size_t tstep = 2 * hstep;
    const unsigned ldsw = (unsigned)wid * 1024u;
    const int aoff = lds_byte(wr * 64 + fr, fq * 8), boff = lds_byte(wc * 32 + fr, fq * 8);
#define PG8_SA(b, h) (((b) * 2 + (h)) * HTB)
#define PG8_SB(b, h) ((4 + (b) * 2 + (h)) * HTB)
#define PG8_STAGE(bufoff, gbase, voff) do { _Pragma("unroll") for (int _i = 0; _i < 2; ++_i) \
        __builtin_amdgcn_global_load_lds((const unsigned*)((const char*)(gbase) + (voff)[_i]), (PG8_LAS unsigned*)(lds + (bufoff) + ldsw + _i * 8192), 16, 0, 0); } while (0)
#define PG8_LDA(dst, b, h) do { _Pragma("unroll") for (int m = 0; m < 4; ++m) _Pragma("unroll") for (int k = 0; k < 2; ++k) dst[m][k] = *(const PG8_LAS bf16x8*)(lds + PG8_SA(b, h) + aoff + m * 2048 + k * 1024); } while (0)
#define PG8_LDB(dst, b, h) do { _Pragma("unroll") for (int n = 0; n < 2; ++n) _Pragma("unroll") for (int k = 0; k < 2; ++k) dst[n][k] = *(const PG8_LAS bf16x8*)(lds + PG8_SB(b, h) + boff + n * 2048 + k * 1024); } while (0)
#define PG8_MMA(ai, bj, At, Bt) do { __builtin_amdgcn_s_setprio(1); _Pragma("unroll") for (int m = 0; m < 4; ++m) _Pragma("unroll") for (int n = 0; n < 2; ++n) _Pragma("unroll") for (int k = 0; k < 2; ++k) \
        acc[ai][bj][m][n] = __builtin_amdgcn_mfma_f32_16x16x32_bf16(Bt[n][k], At[m][k], acc[ai][bj][m][n], 0, 0, 0); __builtin_amdgcn_s_setprio(0); } while (0)
#define PG8_WAIT_V(n) asm volatile("s_waitcnt vmcnt(" #n ")" ::: "memory")
#define PG8_WAIT_L(n) asm volatile("s_waitcnt lgkmcnt(" #n ")" ::: "memory")
#define PG8_BAR __builtin_amdgcn_s_barrier()
#define PG8_SCHED __builtin_amdgcn_sched_barrier(0)
    Unit cur, nxt; int ui = 0;
    if (!S.next(0, cur)) return;
    f32x4 acc[2][2][4][2];
#pragma unroll
    for (int a = 0; a < 2; ++a)
#pragma unroll
        for (int b = 0; b < 2; ++b)
#pragma unroll
            for (int m = 0; m < 4; ++m)
#pragma unroll
                for (int n = 0; n < 2; ++n) acc[a][b][m][n] = (f32x4){0.f, 0.f, 0.f, 0.f};
    bf16x8 At[4][2], B0[2][2], B1[2][2];
    const char* cA = (const char*)g.A + (size_t)cur.pm * tstep; const char* cB = (const char*)g.Bt + (size_t)cur.pn * tstep;
    S.a_ready(cur);
    PG8_STAGE(PG8_SB(0, 0), cB, voffB); PG8_STAGE(PG8_SA(0, 0), cA, voffA); PG8_STAGE(PG8_SB(0, 1), cB + hstep, voffB); PG8_STAGE(PG8_SA(0, 1), cA + hstep, voffA);
    if (wr == 1) PG8_BAR;
    PG8_WAIT_V(4); PG8_BAR;
    PG8_STAGE(PG8_SB(1, 0), cB + kstep, voffB); PG8_STAGE(PG8_SA(1, 0), cA + kstep, voffA); PG8_STAGE(PG8_SB(1, 1), cB + hstep + kstep, voffB);
    PG8_WAIT_V(6); PG8_BAR;
    PG8_STAMP();
    for (;;) {
        const bool has_next = S.next(ui + 1, nxt);
        const char* nA = has_next ? (const char*)g.A + (size_t)nxt.pm * tstep : cA; const char* nB = has_next ? (const char*)g.Bt + (size_t)nxt.pn * tstep : cB;
        for (int t = 0; t < nt; t += 2) {
            const bool last = (t == nt - 2);
            const char* a1 = cA + (size_t)(t + 1) * kstep;
            const char* a2 = last ? nA : cA + (size_t)(t + 2) * kstep; const char* b2 = last ? nB : cB + (size_t)(t + 2) * kstep;
            const char* a3 = a2 + kstep; const char* b3 = b2 + kstep;
            if (last && has_next) S.a_ready(nxt);
            PG8_LDB(B0, 0, 0); PG8_SCHED; PG8_LDA(At, 0, 0); PG8_STAGE(PG8_SA(1, 1), a1 + hstep, voffA);
            PG8_WAIT_L(8); PG8_BAR; PG8_WAIT_L(0); PG8_MMA(0, 0, At, B0); PG8_BAR; PG8_SCHED;
            PG8_LDB(B1, 0, 1); PG8_STAGE(PG8_SB(0, 0), b2, voffB);
            PG8_BAR; PG8_WAIT_L(0); PG8_MMA(0, 1, At, B1); PG8_BAR;
            PG8_LDA(At, 0, 1); PG8_STAGE(PG8_SA(0, 0), a2, voffA);
            PG8_BAR; PG8_WAIT_L(0); PG8_MMA(1, 0, At, B0); PG8_BAR; PG8_SCHED;
            PG8_STAGE(PG8_SB(0, 1), b2 + hstep, voffB);
            PG8_WAIT_V(6); PG8_BAR; PG8_MMA(1, 1, At, B1); PG8_BAR;
            PG8_LDB(B0, 1, 0); PG8_SCHED; PG8_LDA(At, 1, 0); PG8_STAGE(PG8_SA(0, 1), a2 + hstep, voffA);
            PG8_WAIT_L(8); PG8_BAR; PG8_WAIT_L(0); PG8_MMA(0, 0, At, B0); PG8_BAR; PG8_SCHED;
            PG8_LDB(B1, 1, 1); PG8_STAGE(PG8_SB(1, 0), b3, voffB);
            PG8_BAR; PG8_WAIT_L(0); PG8_MMA(0, 1, At, B1); PG8_BAR;
            PG8_LDA(At, 1, 1); PG8_STAGE(PG8_SA(1, 0), a3, voffA);
            PG8_BAR; PG8_WAIT_L(0); PG8_MMA(1, 0, At, B0); PG8_BAR; PG8_SCHED;
            PG8_STAGE(PG8_SB(1, 1), b3 + hstep, voffB);
            PG8_WAIT_V(6); PG8_BAR; PG8_MMA(1, 1, At, B1); PG8_BAR;
        }
        PG8_STAMP();
        if constexpr (!Epi::AFTER_DRAIN) { E(acc, cur, wr, wc, fr, fq); S.done(cur); }
        PG8_STAMP();
        if (!has_next) break;
#pragma unroll
        for (int a = 0; a < 2; ++a)
#pragma unroll
            for (int b = 0; b < 2; ++b)
#pragma unroll
                for (int m = 0; m < 4; ++m)
#pragma unroll
                    for (int n = 0; n < 2; ++n) acc[a][b][m][n] = (f32x4){0.f, 0.f, 0.f, 0.f};
        cur = nxt; cA = nA; cB = nB; ++ui;
    }
    PG8_WAIT_V(0);
    if (wr == 0) PG8_BAR;
    PG8_BAR;
    if constexpr (Epi::AFTER_DRAIN) { E.fused(acc, cur, wr, wc, fr, fq, lds, wid, lane); S.done(cur); }
    PG8_STAMP();
    if (STAMP && wid == 0) { stamps[lane] = lane < nts ? (((unsigned long long)(unsigned)ts_hi << 32) | (unsigned)ts_lo) : 0ull;
        if (lane == 62) stamps[62] = rt_entry; if (lane == 63) stamps[63] = (unsigned long long)wall_clock64(); }
#undef PG8_STAMP
#undef PG8_SA
#undef PG8_SB
#undef PG8_STAGE
#undef PG8_LDA
#undef PG8_LDB
#undef PG8_MMA
#undef PG8_WAIT_V
#undef PG8_WAIT_L
#undef PG8_BAR
#undef PG8_SCHED
}
}

struct EpiZ {
  static constexpr bool PERM = true, AFTER_DRAIN = false;
  unsigned char* ws; float* outp;
  __device__ __forceinline__ void operator()(const pg8::f32x4 (&accin)[2][2][4][2], const pg8::Unit& u, int wr, int wc, int fr, int fq) const {
    u16* Z = (u16*)(ws + OFF_Z);
    float* LR = (float*)(ws + OFF_LR);
    const float* ROPE = (const float*)(ws + OFF_ROPE);
    const bool is_sample = (u.pm * 256) >= NP_TOK;
    const bool upper = fq >= 2;
#pragma unroll
    for (int ai = 0; ai < 2; ++ai)
#pragma unroll
      for (int m = 0; m < 4; ++m) {
        const int row = u.pm * 256 + ai * 128 + wr * 64 + m * 16 + fr;
#pragma unroll
        for (int bj = 0; bj < 2; ++bj) {
          pg8::f32x4 v0 = accin[ai][bj][m][0], v1 = accin[ai][bj][m][1];
          const int cb = u.pn * 256 + bj * 128 + wc * 32 + 8 * fq;
          if (is_sample && (u.pn < 2 || (u.pn == 2 && bj == 0))) {
            const int pos = (row - NP_TOK) & 4095;
            const int pp = (wc & 1) ? (pos & 63) : (pos >> 6);
            const float* tb = ROPE + pp * 16 + 8 * (fq & 1);
            const pg8::f32x4 c0 = *(const pg8::f32x4*)(tb), c1 = *(const pg8::f32x4*)(tb + 4);
            const pg8::f32x4 s0 = *(const pg8::f32x4*)(tb + 1024), s1 = *(const pg8::f32x4*)(tb + 1028);
#pragma unroll
            for (int j = 0; j < 4; ++j) {
              auto r0 = __builtin_amdgcn_permlane32_swap(__float_as_uint(v0[j]), __float_as_uint(v0[j]), false, false);
              const float a1 = __uint_as_float(r0[0]), a2 = __uint_as_float(r0[1]);
              v0[j] = upper ? (a2 * c0[j] + a1 * s0[j]) : (a1 * c0[j] - a2 * s0[j]);
              auto r1 = __builtin_amdgcn_permlane32_swap(__float_as_uint(v1[j]), __float_as_uint(v1[j]), false, false);
              const float b1 = __uint_as_float(r1[0]), b2 = __uint_as_float(r1[1]);
              v1[j] = upper ? (b2 * c1[j] + b1 * s1[j]) : (b1 * c1[j] - b2 * s1[j]);
            }
          }
          if (cb < ZW) *(uint4*)(Z + (size_t)row * ZW + cb) = make_uint4(cvtpk(v0[0], v0[1]), cvtpk(v0[2], v0[3]), cvtpk(v1[0], v1[1]), cvtpk(v1[2], v1[3]));
          if (!is_sample && u.pn == 2) {
            float* dst = (bj == 0) ? (outp + OUT_NK + (size_t)row * 128 + (cb - C_K)) : (outp + OUT_NV + (size_t)row * 128 + (cb - C_V));
            *(pg8::f32x4*)dst = v0; *(pg8::f32x4*)(dst + 4) = v1;
          }
          if (u.pn == 9 && cb < C_ZG) { float* dst = LR + (size_t)row * 32 + (cb - C_LR); *(pg8::f32x4*)dst = v0; *(pg8::f32x4*)(dst + 4) = v1; }
        }
      }
  }
};
struct EpiOut {
  static constexpr bool PERM = true, AFTER_DRAIN = false;
  unsigned char* ws; float* outp; const float* xp; const float* xs;
  __device__ __forceinline__ void operator()(const pg8::f32x4 (&accin)[2][2][4][2], const pg8::Unit& u, int wr, int wc, int fr, int fq) const {
    const float* MOD = (const float*)(ws + OFF_MOD);
    const float* gate = MOD + mod_idx(u.pm * 256) * 3072 + 2048;
    const int cb0 = u.pn * 256 + wc * 32 + 8 * fq;
    pg8::f32x4 gv[2][2];
#pragma unroll
    for (int bj = 0; bj < 2; ++bj) { gv[bj][0] = *(const pg8::f32x4*)(gate + cb0 + bj * 128); gv[bj][1] = *(const pg8::f32x4*)(gate + cb0 + bj * 128 + 4); }
#pragma unroll
    for (int ai = 0; ai < 2; ++ai)
#pragma unroll
      for (int m = 0; m < 4; ++m) {
        const int row = u.pm * 256 + ai * 128 + wr * 64 + m * 16 + fr;
        const float* xr = (row < NP_TOK) ? (xp + (size_t)row * DM) : (xs + (size_t)(row - NP_TOK) * DM);
        u16* orow = (u16*)(ws + OFF_Z) + (size_t)row * DM;
#pragma unroll
        for (int bj = 0; bj < 2; ++bj) {
          const int c = cb0 + bj * 128;
          const pg8::f32x4 x0 = __builtin_nontemporal_load((const pg8::f32x4*)(xr + c)), x1 = __builtin_nontemporal_load((const pg8::f32x4*)(xr + c + 4));
          const pg8::f32x4 o0 = x0 + gv[bj][0] * accin[ai][bj][m][0], o1 = x1 + gv[bj][1] * accin[ai][bj][m][1];
          *(uint4*)(orow + c) = make_uint4(cvtpk(o0[0], o0[1]), cvtpk(o0[2], o0[3]), cvtpk(o1[0], o1[1]), cvtpk(o1[2], o1[3]));
        }
      }
  }
};

__device__ void vt_task(const Params& p, int task, unsigned char* smem, const int tid) {
  u16* T = (u16*)smem;
  const u16* Z = (const u16*)(p.ws + OFF_Z);
  u16* VT = (u16*)(p.ws + OFF_VTG);
  u16* KC = (u16*)(p.ws + OFF_KC);
  const int chunk = task >> 1, kvh = task & 1;
  const int tok = tid >> 2, c = tid & 3;
  if (chunk < 384) {
    const uint4* src = (const uint4*)(Z + (size_t)(chunk * 64 + tok) * ZW + C_V + kvh * 64 + c * 16);
    const uint4 a0 = src[0], a1 = src[1];
    *(uint4*)&T[tok * 72 + c * 16] = a0;
    *(uint4*)&T[tok * 72 + c * 16 + 8] = a1;
  } else {
    const size_t off = ((size_t)((chunk - 384) * 64 + tok) * 2 + kvh) * 64 + c * 16;
    const float4* vs = (const float4*)(p.cache_v + off);
    const float4* ks = (const float4*)(p.cache_k + off);
    const float4 v0 = vs[0], v1 = vs[1], v2 = vs[2], v3 = vs[3];
    const float4 k0 = ks[0], k1 = ks[1], k2 = ks[2], k3 = ks[3];
    *(uint4*)&T[tok * 72 + c * 16] = make_uint4(pack2(v0.x, v0.y), pack2(v0.z, v0.w), pack2(v1.x, v1.y), pack2(v1.z, v1.w));
    *(uint4*)&T[tok * 72 + c * 16 + 8] = make_uint4(pack2(v2.x, v2.y), pack2(v2.z, v2.w), pack2(v3.x, v3.y), pack2(v3.z, v3.w));
    uint4* kd = (uint4*)(KC + off);
    kd[0] = make_uint4(pack2(k0.x, k0.y), pack2(k0.z, k0.w), pack2(k1.x, k1.y), pack2(k1.z, k1.w));
    kd[1] = make_uint4(pack2(k2.x, k2.y), pack2(k2.z, k2.w), pack2(k3.x, k3.y), pack2(k3.z, k3.w));
  }
  __syncthreads();
  {
    const int d = tid >> 2;
    unsigned o[8];
#pragma unroll
    for (int j = 0; j < 8; ++j) {
      const int p0 = 2 * j, p1 = 2 * j + 1;
      const int k0 = (p0 & 3) | ((p0 & 4) << 1) | ((p0 & 8) >> 1);
      const int k1 = (p1 & 3) | ((p1 & 4) << 1) | ((p1 & 8) >> 1);
      o[j] = (unsigned)T[(c * 16 + k0) * 72 + d] | ((unsigned)T[(c * 16 + k1) * 72 + d] << 16);
    }
    uint4* dst = (uint4*)(VT + (size_t)(kvh * 64 + d) * TTOT + chunk * 64 + c * 16);
    dst[0] = make_uint4(o[0], o[1], o[2], o[3]);
    dst[1] = make_uint4(o[4], o[5], o[6], o[7]);
  }
  __syncthreads();
}

struct TInfo { bool from_cache, masked, allmask; int kbase; };
__device__ __forceinline__ TInfo tile_info(bool latent, int qb, int ti) {
  TInfo t; t.from_cache = false; t.masked = false; t.allmask = false; t.kbase = 0;
  if (latent) {
    if (ti < 6) {
      t.kbase = (qb - 1) * 128 + ti * 64; t.masked = true;
      if (t.kbase < 0 || t.kbase >= 4096) { t.allmask = true; t.kbase = 0; }
    } else { t.from_cache = true; t.kbase = (ti - 6) * 64; }
  } else t.kbase = ti * 64;
  return t;
}
__device__ __forceinline__ float u2f(unsigned u) { return __uint_as_float(u); }

__device__ void attn_item(const Params& p, int item, unsigned char* smem, const int tid) {
  const u16* Z = (const u16*)(p.ws + OFF_Z);
  u16* Y = (u16*)(p.ws + OFF_HY);
  const int lane = tid & 63, w = __builtin_amdgcn_readfirstlane(tid >> 6), r = lane & 31, hh = lane >> 5;
  const bool latent = item < 1024;
  int b, kvh, g, qb, seq0;
  if (latent) { g = item & 3; qb = (item >> 2) & 31; kvh = (item >> 7) & 1; b = item >> 8; seq0 = NP_TOK + b * 4096; }
  else { int it = item - 1024; g = it & 3; qb = (it >> 2) & 1; kvh = (it >> 3) & 1; b = it >> 4; seq0 = b * 256; }
  const int h = kvh * 4 + g;
  const int t0 = seq0 + qb * 128;
  bf16x8 qf[4];
  {
    const u16* qptr = Z + (size_t)(t0 + w * 32 + r) * ZW + C_Q + h * 64 + hh * 8;
#pragma unroll
    for (int ks = 0; ks < 4; ++ks) qf[ks] = *(const bf16x8*)(qptr + ks * 16);
  }
  float m = p.sink[h] * 1.4426950408889634f, l = hh ? 0.f : 1.f;
  f32x16 O0, O1;
#pragma unroll
  for (int i = 0; i < 16; ++i) { O0[i] = 0.f; O1[i] = 0.f; }
  const int ntiles = latent ? 14 : 4;
  const int qpos = qb * 128 + w * 32 + r;
  const int key = tid >> 2, dq = (tid & 3) * 16;
  const u16* VT = (const u16*)(p.ws + OFF_VTG);
  const u16* KC = (const u16*)(p.ws + OFF_KC);
  uint4 r0, r1, r2, r3;
  r0 = r1 = r2 = r3 = make_uint4(0u, 0u, 0u, 0u);
#define ATT_LOAD(ti_)                                                                                  \
  {                                                                                                    \
    const TInfo tt = tile_info(latent, qb, (ti_));                                                     \
    const u16* ksrc = tt.from_cache ? (KC + ((size_t)(b * 512 + tt.kbase + key) * 2 + kvh) * 64 + dq)   \
                                    : (Z + (size_t)(seq0 + tt.kbase + key) * ZW + C_K + kvh * 64 + dq); \
    const int slot = tt.from_cache ? (T_TOK + b * 512 + tt.kbase) : (seq0 + tt.kbase);                 \
    const u16* vsrc = VT + (size_t)(kvh * 64 + key) * TTOT + slot + dq;                                \
    r0 = *(const uint4*)(ksrc); r1 = *(const uint4*)(ksrc + 8);                                        \
    r2 = *(const uint4*)(vsrc); r3 = *(const uint4*)(vsrc + 8);                                        \
  }
#define ATT_STORE(ti_, buf_)                                                                           \
  {                                                                                                    \
    u16* Ksw = (u16*)(smem + (buf_) * 18432);                                                          \
    u16* Vtw = Ksw + 64 * 72;                                                                          \
    *(uint4*)&Ksw[key * 72 + dq] = r0;                                                                 \
    *(uint4*)&Ksw[key * 72 + dq + 8] = r1;                                                             \
    *(uint4*)&Vtw[key * 72 + dq] = r2;                                                                 \
    *(uint4*)&Vtw[key * 72 + dq + 8] = r3;                                                             \
  }
  ATT_LOAD(0)
  ATT_STORE(0, 0)
  ATT_LOAD(1)
  __syncthreads();
  for (int ti = 0; ti < ntiles; ++ti) {
    const TInfo tc = tile_info(latent, qb, ti);
    const u16* Ks = (const u16*)(smem + (ti & 1) * 18432);
    const u16* Vt = Ks + 64 * 72;
    f32x16 S[2];
#pragma unroll
    for (int mb = 0; mb < 2; ++mb) {
#pragma unroll
      for (int i = 0; i < 16; ++i) S[mb][i] = 0.f;
#pragma unroll
      for (int ks = 0; ks < 4; ++ks) {
        bf16x8 a = *(const bf16x8*)&Ks[(mb * 32 + r) * 72 + ks * 16 + hh * 8];
        S[mb] = mfma32(a, qf[ks], S[mb]);
      }
    }
    const int q0w = qb * 128 + w * 32;
    const bool need_mask = tc.masked && (tc.allmask || (q0w + 31 - tc.kbase > 128) || (tc.kbase + 63 - q0w > 128));
    float mx = -3.0e38f;
    if (need_mask) {
#pragma unroll
      for (int mb = 0; mb < 2; ++mb)
#pragma unroll
        for (int i = 0; i < 16; ++i) {
          float sv = S[mb][i];
          int kpos = tc.kbase + mb * 32 + rowmap(i, hh);
          int d = qpos - kpos;
          if (d > 128 || d < -128 || tc.allmask) sv = -1e30f;
          S[mb][i] = sv;
          mx = fmaxf(mx, sv);
        }
    } else {
#pragma unroll
      for (int mb = 0; mb < 2; ++mb)
#pragma unroll
        for (int i = 0; i < 16; ++i) mx = fmaxf(mx, S[mb][i]);
    }
    mx = fmaxf(mx, __shfl_xor(mx, 32)) * 0.18033688011112042f;
    const float mnew = fmaxf(m, mx);
    if (__builtin_amdgcn_ballot_w64(mx > m + 8.0f) != 0ull) {
      const float alpha = __builtin_amdgcn_exp2f(m - mnew);
      l *= alpha;
#pragma unroll
      for (int i = 0; i < 16; ++i) { O0[i] *= alpha; O1[i] *= alpha; }
      m = mnew;
    }
    float rs = 0.f;
#pragma unroll
    for (int mb = 0; mb < 2; ++mb)
#pragma unroll
      for (int i = 0; i < 16; ++i) {
        float pv = __builtin_amdgcn_exp2f(fmaf(S[mb][i], 0.18033688011112042f, -m));
        S[mb][i] = pv;
        rs += pv;
      }
    l += rs;
#pragma unroll
    for (int mb = 0; mb < 2; ++mb)
#pragma unroll
      for (int s2 = 0; s2 < 2; ++s2) {
        u32x4 pku;
        pku.x = pack2(S[mb][8 * s2 + 0], S[mb][8 * s2 + 1]);
        pku.y = pack2(S[mb][8 * s2 + 2], S[mb][8 * s2 + 3]);
        pku.z = pack2(S[mb][8 * s2 + 4], S[mb][8 * s2 + 5]);
        pku.w = pack2(S[mb][8 * s2 + 6], S[mb][8 * s2 + 7]);
        const bf16x8 pkv = __builtin_bit_cast(bf16x8, pku);
        const int kk = mb * 32 + 16 * s2 + 8 * hh;
        O0 = mfma32(*(const bf16x8*)&Vt[r * 72 + kk], pkv, O0);
        O1 = mfma32(*(const bf16x8*)&Vt[(32 + r) * 72 + kk], pkv, O1);
      }
    if (ti + 1 < ntiles) ATT_STORE(ti + 1, (ti + 1) & 1)
    if (ti + 2 < ntiles) ATT_LOAD(ti + 2)
    __syncthreads();
  }
  l += __shfl_xor(l, 32);
  const float inv = 1.f / l;
  float* Ow = (float*)smem + w * 32 * 68;
#pragma unroll
  for (int g4 = 0; g4 < 4; ++g4) {
    *(float4*)&Ow[r * 68 + 8 * g4 + 4 * hh] = make_float4(O0[4 * g4 + 0] * inv, O0[4 * g4 + 1] * inv, O0[4 * g4 + 2] * inv, O0[4 * g4 + 3] * inv);
    *(float4*)&Ow[r * 68 + 32 + 8 * g4 + 4 * hh] = make_float4(O1[4 * g4 + 0] * inv, O1[4 * g4 + 1] * inv, O1[4 * g4 + 2] * inv, O1[4 * g4 + 3] * inv);
  }
  __syncthreads();
#pragma unroll
  for (int i = 0; i < 4; ++i) {
    int idx = lane + 64 * i;
    int row = idx >> 3, c8 = (idx & 7) * 8;
    int t = t0 + w * 32 + row;
    float4 o0 = *(const float4*)&Ow[row * 68 + c8];
    float4 o1 = *(const float4*)&Ow[row * 68 + c8 + 4];
    uint4 za = ldnt16(Z + (size_t)t * ZW + C_ZA + h * 64 + c8);
    uint4 yo;
    yo.x = pack2(o0.x * siluf(bflo(za.x)), o0.y * siluf(bfhi(za.x)));
    yo.y = pack2(o0.z * siluf(bflo(za.y)), o0.w * siluf(bfhi(za.y)));
    yo.z = pack2(o1.x * siluf(bflo(za.z)), o1.y * siluf(bfhi(za.z)));
    yo.w = pack2(o1.z * siluf(bflo(za.w)), o1.w * siluf(bfhi(za.w)));
    *(uint4*)(Y + (size_t)t * DM + h * 64 + c8) = yo;
  }
  __syncthreads();
#undef ATT_LOAD
#undef ATT_STORE
}

__device__ __forceinline__ void gla_gates(const Params& p, int t0, int h, unsigned char* smem, float* part, float (&gcf)[16],
                                          float (&gcb)[16], float& gtf, float& gtb, const int tid) {
  const int dk = tid & 63, tq = tid >> 6;
  const float* LR = (const float*)(p.ws + OFF_LR);
  float* pre = (float*)smem;
  {
    const int lane = tid & 63, w = tid >> 6, r = lane & 31, hh = lane >> 5;
    const int dir = w & 1, nbk = w >> 1;
    const float* Wg = (dir ? p.w_gk_b : p.w_gk_f) + h * 64 + nbk * 32 + r;
    float wv[8];
#pragma unroll
    for (int j = 0; j < 8; ++j) wv[j] = Wg[(8 * hh + j) * 256];
    u32x4 bh, bl;
    {
      unsigned h0 = cvtpk(wv[0], wv[1]), h1 = cvtpk(wv[2], wv[3]), h2 = cvtpk(wv[4], wv[5]), h3 = cvtpk(wv[6], wv[7]);
      bh.x = h0; bh.y = h1; bh.z = h2; bh.w = h3;
      bl.x = cvtpk(wv[0] - bflo(h0), wv[1] - bfhi(h0)); bl.y = cvtpk(wv[2] - bflo(h1), wv[3] - bfhi(h1));
      bl.z = cvtpk(wv[4] - bflo(h2), wv[5] - bfhi(h2)); bl.w = cvtpk(wv[6] - bflo(h3), wv[7] - bfhi(h3));
    }
#pragma unroll
    for (int mb = 0; mb < 2; ++mb) {
      const float4* lp = (const float4*)(LR + (size_t)(t0 + mb * 32 + r) * 32 + dir * 16 + 8 * hh);
      const float4 x0 = lp[0], x1 = lp[1];
      u32x4 ah, al;
      ah.x = cvtpk(x0.x, x0.y); ah.y = cvtpk(x0.z, x0.w); ah.z = cvtpk(x1.x, x1.y); ah.w = cvtpk(x1.z, x1.w);
      al.x = cvtpk(x0.x - bflo(ah.x), x0.y - bfhi(ah.x)); al.y = cvtpk(x0.z - bflo(ah.y), x0.w - bfhi(ah.y));
      al.z = cvtpk(x1.x - bflo(ah.z), x1.y - bfhi(ah.z)); al.w = cvtpk(x1.z - bflo(ah.w), x1.w - bfhi(ah.w));
      f32x16 acc;
#pragma unroll
      for (int i = 0; i < 16; ++i) acc[i] = 0.f;
      acc = mfma32(__builtin_bit_cast(bf16x8, al), __builtin_bit_cast(bf16x8, bh), acc);
      acc = mfma32(__builtin_bit_cast(bf16x8, ah), __builtin_bit_cast(bf16x8, bl), acc);
      acc = mfma32(__builtin_bit_cast(bf16x8, ah), __builtin_bit_cast(bf16x8, bh), acc);
#pragma unroll
      for (int i = 0; i < 16; ++i) pre[dir * 4096 + (mb * 32 + rowmap(i, hh)) * 64 + nbk * 32 + r] = acc[i];
    }
  }
  __syncthreads();
  const float bf = p.b_gk_f[h * 64 + dk], bb = p.b_gk_b[h * 64 + dk];
#pragma unroll
  for (int j = 0; j < 16; ++j) {
    gcf[j] = logsigf(pre[(tq * 16 + j) * 64 + dk] + bf) * 0.0625f;
    gcb[j] = logsigf(pre[4096 + (tq * 16 + j) * 64 + dk] + bb) * 0.0625f;
  }
#pragma unroll
  for (int j = 1; j < 16; ++j) gcf[j] += gcf[j - 1];
#pragma unroll
  for (int j = 14; j >= 0; --j) gcb[j] += gcb[j + 1];
  part[tq * 64 + dk] = gcf[15];
  part[(4 + tq) * 64 + dk] = gcb[0];
  __syncthreads();
  float offf = 0.f, offb = 0.f;
  gtf = 0.f; gtb = 0.f;
#pragma unroll
  for (int q = 0; q < 4; ++q) {
    float a = part[q * 64 + dk], bq = part[(4 + q) * 64 + dk];
    gtf += a; gtb += bq;
    if (q < tq) offf += a;
    if (q > tq) offb += bq;
  }
#pragma unroll
  for (int j = 0; j < 16; ++j) { gcf[j] += offf; gcb[j] += offb; }
}

struct VRegs { uint4 a, b, c, d; };
__device__ __forceinline__ VRegs load_v(const u16* Z, int t0, int h, const int tid) {
  const int tok = tid >> 2, dq = (tid & 3) * 32;
  const uint4* src = (const uint4*)(Z + (size_t)(t0 + tok) * ZW + C_VG + h * 128 + dq);
  VRegs v; v.a = src[0]; v.b = src[1]; v.c = src[2]; v.d = src[3];
  return v;
}
__device__ __forceinline__ void store_vt(const VRegs& v, u16* Vt, const int tid) {
  const int tok = tid >> 2, dq = (tid & 3) * 32;
#define VTG(i, e, val) Vt[(dq + (i) * 8 + 2 * (e)) * 72 + tok] = (u16)((val) & 0xffffu); Vt[(dq + (i) * 8 + 2 * (e) + 1) * 72 + tok] = (u16)((val) >> 16);
  VTG(0, 0, v.a.x) VTG(0, 1, v.a.y) VTG(0, 2, v.a.z) VTG(0, 3, v.a.w)
  VTG(1, 0, v.b.x) VTG(1, 1, v.b.y) VTG(1, 2, v.b.z) VTG(1, 3, v.b.w)
  VTG(2, 0, v.c.x) VTG(2, 1, v.c.y) VTG(2, 2, v.c.z) VTG(2, 3, v.c.w)
  VTG(3, 0, v.d.x) VTG(3, 1, v.d.y) VTG(3, 2, v.d.z) VTG(3, 3, v.d.w)
#undef VTG
}

__device__ __forceinline__ int spt_off(int dv, int dk) { return (dv >> 5) * 2048 + (dk >> 4) * 512 + (dv & 31) * 16 + ((dk >> 3) & 1) * 8 + (dk & 7); }
__device__ void gla_ds_task(const Params& p, int task, unsigned char* smem, const int tid) {
  const int cgk = task >> 2, h = task & 3, t0 = cgk * 64;
  u16* KeF = (u16*)smem;
  u16* KeB = KeF + 64 * 72;
  u16* Vt = KeB + 64 * 72;
  float* part = (float*)(Vt + 128 * 72);
  const u16* Z = (const u16*)(p.ws + OFF_Z);
  u16* DSB = (u16*)(p.ws + OFF_SPT);
  float* DEC = (float*)(p.ws + OFF_DEC);
  const int lane = tid & 63, w = tid >> 6, r = lane & 31, hh = lane >> 5;
  const int dk = tid & 63, tq = tid >> 6;
  u16* RK = (u16*)(smem + 40960);
  {
    const uint4* ks_ = (const uint4*)(Z + (size_t)(t0 + (tid >> 2)) * ZW + C_KG + h * 64 + (tid & 3) * 16);
    const uint4 k0 = ks_[0], k1 = ks_[1];
    *(uint4*)&RK[(tid >> 2) * 72 + (tid & 3) * 16] = k0;
    *(uint4*)&RK[(tid >> 2) * 72 + (tid & 3) * 16 + 8] = k1;
  }
  const VRegs vr = load_v(Z, t0, h, tid);
  float gcf[16], gcb[16], gtf, gtb;
  gla_gates(p, t0, h, smem, part, gcf, gcb, gtf, gtb, tid);
  u16 kraw[16];
#pragma unroll
  for (int j = 0; j < 16; ++j) kraw[j] = RK[(tq * 16 + j) * 72 + dk];
  {
    unsigned kf[8], kb[8];
#pragma unroll
    for (int j = 0; j < 8; ++j) {
      const float k0 = bf2f(kraw[2 * j]), k1 = bf2f(kraw[2 * j + 1]);
      kf[j] = pack2(k0 * __expf(gtf - gcf[2 * j]), k1 * __expf(gtf - gcf[2 * j + 1]));
      kb[j] = pack2(k0 * __expf(gtb - gcb[2 * j]), k1 * __expf(gtb - gcb[2 * j + 1]));
    }
    *(uint4*)&KeF[dk * 72 + tq * 16] = make_uint4(kf[0], kf[1], kf[2], kf[3]);
    *(uint4*)&KeF[dk * 72 + tq * 16 + 8] = make_uint4(kf[4], kf[5], kf[6], kf[7]);
    *(uint4*)&KeB[dk * 72 + tq * 16] = make_uint4(kb[0], kb[1], kb[2], kb[3]);
    *(uint4*)&KeB[dk * 72 + tq * 16 + 8] = make_uint4(kb[4], kb[5], kb[6], kb[7]);
  }
  if (tq == 0) {
    DEC[(size_t)(task * 2 + 0) * 64 + dk] = __expf(gtf);
    DEC[(size_t)(task * 2 + 1) * 64 + dk] = __expf(gtb);
  }
  store_vt(vr, Vt, tid);
  __syncthreads();
  {
#pragma unroll
    for (int dir = 0; dir < 2; ++dir) {
      const u16* Ke = dir ? KeB : KeF;
#pragma unroll
      for (int nb2 = 0; nb2 < 2; ++nb2) {
        f32x16 acc;
#pragma unroll
        for (int i = 0; i < 16; ++i) acc[i] = 0.f;
#pragma unroll
        for (int ks = 0; ks < 4; ++ks) {
          bf16x8 a = *(const bf16x8*)&Ke[(nb2 * 32 + r) * 72 + ks * 16 + hh * 8];
          bf16x8 bq = *(const bf16x8*)&Vt[(w * 32 + r) * 72 + ks * 16 + hh * 8];
          acc = mfma32(a, bq, acc);
        }
        u16* dst = DSB + (size_t)(task * 2 + dir) * 8192 + w * 2048 + (nb2 * 2) * 512 + r * 16 + hh * 8;
#pragma unroll
        for (int k = 0; k < 4; k += 2) {
          unsigned ax = pack2(acc[4 * k + 0], acc[4 * k + 1]), ay = pack2(acc[4 * k + 2], acc[4 * k + 3]);
          unsigned bx = pack2(acc[4 * k + 4], acc[4 * k + 5]), by = pack2(acc[4 * k + 6], acc[4 * k + 7]);
          auto rx = __builtin_amdgcn_permlane32_swap(ax, bx, false, false);
          auto ry = __builtin_amdgcn_permlane32_swap(ay, by, false, false);
          *(uint4*)(dst + (k >> 1) * 512) = make_uint4(rx[0], ry[0], rx[1], ry[1]);
        }
      }
    }
  }
  __syncthreads();
}

__device__ void gla_scan_task(const Params& p, int task, const int tid) {
  const float* DEC = (const float*)(p.ws + OFF_DEC);
  u16* SPT = (u16*)(p.ws + OFF_SPT);
  const int chain = task >> 4, part = task & 15, b = chain >> 3, h = (chain >> 1) & 3, dir = chain & 1, cgbase = 128 + b * 64;
  const int e2 = part * 256 + tid;
  const int o2 = e2 * 2;
  const int dv = (o2 >> 11) * 32 + ((o2 >> 4) & 31), dk2 = ((o2 >> 9) & 3) * 16 + ((o2 >> 3) & 1) * 8 + (o2 & 7);
  const float* sg = p.state_gla + ((size_t)((b * 2 + dir) * 4 + h)) * 8192;
  float2 s = make_float2(sg[(dk2 + 0) * 128 + dv], sg[(dk2 + 1) * 128 + dv]);
  for (int i0 = 0; i0 < 64; i0 += 16) {
    unsigned du[16]; float2 dc[16];
#pragma unroll
    for (int j = 0; j < 16; ++j) {
      const int c = dir ? (63 - i0 - j) : (i0 + j);
      const size_t idx = (size_t)((cgbase + c) * 4 + h) * 2 + dir;
      du[j] = *(const unsigned*)(SPT + idx * 8192 + (size_t)e2 * 2);
      dc[j] = *(const float2*)(DEC + idx * 64 + dk2);
    }
#pragma unroll
    for (int j = 0; j < 16; ++j) {
      const int c = dir ? (63 - i0 - j) : (i0 + j);
      const size_t idx = (size_t)((cgbase + c) * 4 + h) * 2 + dir;
      *(unsigned*)(SPT + idx * 8192 + (size_t)e2 * 2) = pack2(s.x, s.y);
      s.x = dc[j].x * s.x + bflo(du[j]); s.y = dc[j].y * s.y + bfhi(du[j]);
    }
  }
}

__device__ void gla_scan_prompt4(const Params& p, int q, const int tid) {
  const float* DEC = (const float*)(p.ws + OFF_DEC);
  u16* SPT = (u16*)(p.ws + OFF_SPT);
  const int chain = q >> 2, b = chain >> 3, h = (chain >> 1) & 3, dir = chain & 1, cgbase = b * 4;
  const size_t sbase = ((size_t)((b * 2 + dir) * 4 + h)) * 8192;
  const int dv = (q & 3) * 32 + ((tid >> 3) & 31);
  const int dkl = ((tid >> 2) & 1) * 8 + (tid & 3) * 2;
  unsigned d[4][4]; float2 dc[4][4];
#pragma unroll
  for (int i = 0; i < 4; ++i) {
    const int c = dir ? (3 - i) : i;
    const size_t idx = (size_t)((cgbase + c) * 4 + h) * 2 + dir;
#pragma unroll
    for (int pp = 0; pp < 4; ++pp) {
      const int e2 = ((q & 3) * 4 + pp) * 256 + tid;
      d[pp][i] = *(const unsigned*)(SPT + idx * 8192 + (size_t)e2 * 2);
      dc[pp][i] = *(const float2*)(DEC + idx * 64 + pp * 16 + dkl);
    }
  }
#pragma unroll
  for (int pp = 0; pp < 4; ++pp) {
    const int e2 = ((q & 3) * 4 + pp) * 256 + tid;
    const int dk2 = pp * 16 + dkl;
    float2 sv = make_float2(0.f, 0.f);
#pragma unroll
    for (int i = 0; i < 4; ++i) {
      const int c = dir ? (3 - i) : i;
      const size_t idx = (size_t)((cgbase + c) * 4 + h) * 2 + dir;
      *(unsigned*)(SPT + idx * 8192 + (size_t)e2 * 2) = pack2(sv.x, sv.y);
      sv.x = dc[pp][i].x * sv.x + bflo(d[pp][i]); sv.y = dc[pp][i].y * sv.y + bfhi(d[pp][i]);
    }
    float* ns = p.out + OUT_NS + sbase;
    ns[(dk2 + 0) * 128 + dv] = sv.x; ns[(dk2 + 1) * 128 + dv] = sv.y;
  }
}

__device__ void gla_out_task(const Params& p, int task, unsigned char* smem, const int tid) {
  const int cgk = task >> 2, h = task & 3, t0 = cgk * 64;
  u16* QdF = (u16*)smem;
  u16* QdB = QdF + 64 * 72;
  u16* KiF = QdB + 64 * 72;
  u16* KiB = KiF + 64 * 72;
  u16* Vt = KiB + 64 * 72;
  float* part = (float*)(Vt + 128 * 72);
  float* ssq = part + 512;
  float* Os = (float*)smem;
  const u16* Z = (const u16*)(p.ws + OFF_Z);
  const u16* SPT = (const u16*)(p.ws + OFF_SPT);
  u16* Y = (u16*)(p.ws + OFF_HY);
  const int lane = tid & 63, w = tid >> 6, r = lane & 31, hh = lane >> 5;
  const int dk = tid & 63, tq = tid >> 6;
  u16* RQ = Vt;
  u16* RK = Vt + 64 * 72;
  {
    const u16* zr = Z + (size_t)(t0 + (tid >> 2)) * ZW + h * 64 + (tid & 3) * 16;
    const uint4 q0 = ldnt16(zr + C_QG), q1 = ldnt16(zr + C_QG + 8);
    const uint4 k0 = ldnt16(zr + C_KG), k1 = ldnt16(zr + C_KG + 8);
    *(uint4*)&RQ[(tid >> 2) * 72 + (tid & 3) * 16] = q0; *(uint4*)&RQ[(tid >> 2) * 72 + (tid & 3) * 16 + 8] = q1;
    *(uint4*)&RK[(tid >> 2) * 72 + (tid & 3) * 16] = k0; *(uint4*)&RK[(tid >> 2) * 72 + (tid & 3) * 16 + 8] = k1;
  }
  const VRegs vr = load_v(Z, t0, h, tid);
  {
    float gcf[16], gcb[16], gtf, gtb;
    gla_gates(p, t0, h, smem, part, gcf, gcb, gtf, gtb, tid);
#pragma unroll
    for (int j = 0; j < 16; ++j) {
      int tok = tq * 16 + j;
      float q = bf2f(RQ[tok * 72 + dk]) * 0.125f, k = bf2f(RK[tok * 72 + dk]);
      QdF[tok * 72 + dk] = f2bf(q * __expf(gcf[j]));
      QdB[tok * 72 + dk] = f2bf(q * __expf(gcb[j]));
      KiF[tok * 72 + dk] = f2bf(k * __expf(-gcf[j]));
      KiB[tok * 72 + dk] = f2bf(k * __expf(-gcb[j]));
    }
  }
  __syncthreads();
  store_vt(vr, Vt, tid);
  __syncthreads();
  const int ib = w & 1, dh = w >> 1;
  bf16x8 qF[4], qB[4];
#pragma unroll
  for (int ks = 0; ks < 4; ++ks) {
    qF[ks] = *(const bf16x8*)&QdF[(ib * 32 + r) * 72 + ks * 16 + hh * 8];
    qB[ks] = *(const bf16x8*)&QdB[(ib * 32 + r) * 72 + ks * 16 + hh * 8];
  }
  f32x16 comb[2];
  const int ii = ib * 32 + r;
#pragma unroll
  for (int mb = 0; mb < 2; ++mb) {
    f32x16 xf, xb;
#pragma unroll
    for (int i = 0; i < 16; ++i) { xf[i] = 0.f; xb[i] = 0.f; }
#pragma unroll
    for (int ks = 0; ks < 4; ++ks) {
      bf16x8 a = *(const bf16x8*)&KiF[(mb * 32 + r) * 72 + ks * 16 + hh * 8];
      xf = mfma32(a, qF[ks], xf);
      bf16x8 a2 = *(const bf16x8*)&KiB[(mb * 32 + r) * 72 + ks * 16 + hh * 8];
      xb = mfma32(a2, qB[ks], xb);
    }
#pragma unroll
    for (int i = 0; i < 16; ++i) {
      int jj = mb * 32 + rowmap(i, hh);
      comb[mb][i] = ((ii >= jj) ? xf[i] : 0.f) + ((ii <= jj) ? xb[i] : 0.f);
    }
  }
  f32x16 o[2];
#pragma unroll
  for (int db = 0; db < 2; ++db) {
#pragma unroll
    for (int i = 0; i < 16; ++i) o[db][i] = 0.f;
    const int dvrow = dh * 64 + db * 32 + r;
#pragma unroll
    for (int mb = 0; mb < 2; ++mb)
#pragma unroll
      for (int s = 0; s < 2; ++s) {
        u32x4 pku;
        pku.x = pack2(comb[mb][8 * s + 0], comb[mb][8 * s + 1]);
        pku.y = pack2(comb[mb][8 * s + 2], comb[mb][8 * s + 3]);
        pku.z = pack2(comb[mb][8 * s + 4], comb[mb][8 * s + 5]);
        pku.w = pack2(comb[mb][8 * s + 6], comb[mb][8 * s + 7]);
        const int kk = mb * 32 + 16 * s + 4 * hh;
        uint2 q0 = *(const uint2*)&Vt[dvrow * 72 + kk];
        uint2 q1 = *(const uint2*)&Vt[dvrow * 72 + kk + 8];
        u32x4 au; au.x = q0.x; au.y = q0.y; au.z = q1.x; au.w = q1.y;
        o[db] = mfma32(__builtin_bit_cast(bf16x8, au), __builtin_bit_cast(bf16x8, pku), o[db]);
      }
    const u16* sf = SPT + (size_t)(task * 2 + 0) * 8192 + (dh * 2 + db) * 2048 + r * 16 + hh * 8;
    const u16* sb = SPT + (size_t)(task * 2 + 1) * 8192 + (dh * 2 + db) * 2048 + r * 16 + hh * 8;
#pragma unroll
    for (int ks = 0; ks < 4; ++ks) {
      bf16x8 a = __builtin_nontemporal_load((const bf16x8*)(sf + ks * 512));
      o[db] = mfma32(a, qF[ks], o[db]);
      bf16x8 a2 = __builtin_nontemporal_load((const bf16x8*)(sb + ks * 512));
      o[db] = mfma32(a2, qB[ks], o[db]);
    }
  }
  float ss = 0.f;
#pragma unroll
  for (int db = 0; db < 2; ++db)
#pragma unroll
    for (int i = 0; i < 16; ++i) ss += o[db][i] * o[db][i];
  ss += __shfl_xor(ss, 32);
  if (hh == 0) ssq[dh * 64 + ii] = ss;
  __syncthreads();
  const float rstd = rsqrtf((ssq[ii] + ssq[64 + ii]) * (1.f / 128.f) + EPSV);
#pragma unroll
  for (int db = 0; db < 2; ++db)
#pragma unroll
    for (int g4 = 0; g4 < 4; ++g4)
      *(float4*)&Os[ii * 132 + dh * 64 + db * 32 + 8 * g4 + 4 * hh] =
          make_float4(o[db][4 * g4 + 0] * rstd, o[db][4 * g4 + 1] * rstd, o[db][4 * g4 + 2] * rstd, o[db][4 * g4 + 3] * rstd);
  __syncthreads();
#pragma unroll
  for (int i = 0; i < 4; ++i) {
    int idx = tid + 256 * i;
    int tok = idx >> 4, c8 = (idx & 15) * 8;
    float4 o0 = *(const float4*)&Os[tok * 132 + c8];
    float4 o1 = *(const float4*)&Os[tok * 132 + c8 + 4];
    float4 g0 = *(const float4*)(p.gla_norm_g + c8);
    float4 g1 = *(const float4*)(p.gla_norm_g + c8 + 4);
    uint4 zg = ldnt16(Z + (size_t)(t0 + tok) * ZW + C_ZG + h * 128 + c8);
    uint4 yo;
    yo.x = pack2(o0.x * g0.x * siluf(bflo(zg.x)), o0.y * g0.y * siluf(bfhi(zg.x)));
    yo.y = pack2(o0.z * g0.z * siluf(bflo(zg.y)), o0.w * g0.w * siluf(bfhi(zg.y)));
    yo.z = pack2(o1.x * g1.x * siluf(bflo(zg.z)), o1.y * g1.y * siluf(bfhi(zg.z)));
    yo.w = pack2(o1.z * g1.z * siluf(bflo(zg.w)), o1.w * g1.w * siluf(bfhi(zg.w)));
    *(uint4*)(Y + (size_t)(t0 + tok) * DM + 512 + h * 128 + c8) = yo;
  }
  __syncthreads();
}

__device__ void final_rows(const Params& p) {
  const int thr = opq(threadIdx.x);
  const int lane = thr & 63, w = thr >> 6;
  const u16* XN = (const u16*)(p.ws + OFF_Z);
  float4 g[4];
#pragma unroll
  for (int i = 0; i < 4; ++i) g[i] = *(const float4*)(p.final_norm_g + i * 256 + lane * 4);
  const int stride = gridDim.x * 8;
  for (int row = blockIdx.x * 8 + w; row < T_TOK; row += 2 * stride) {
    const int row1 = row + stride;
    const bool has1 = row1 < T_TOK;
    const u16* x0 = XN + (size_t)row * DM;
    const u16* x1 = XN + (size_t)(has1 ? row1 : row) * DM;
    uint2 u0[4], u1[4];
#pragma unroll
    for (int i = 0; i < 4; ++i) { u0[i] = ldnt8(x0 + i * 256 + lane * 4); u1[i] = ldnt8(x1 + i * 256 + lane * 4); }
    float4 v0[4], v1[4];
    float ss0 = 0.f, ss1 = 0.f;
#pragma unroll
    for (int i = 0; i < 4; ++i) {
      v0[i] = make_float4(bflo(u0[i].x), bfhi(u0[i].x), bflo(u0[i].y), bfhi(u0[i].y));
      v1[i] = make_float4(bflo(u1[i].x), bfhi(u1[i].x), bflo(u1[i].y), bfhi(u1[i].y));
      ss0 += v0[i].x * v0[i].x + v0[i].y * v0[i].y + v0[i].z * v0[i].z + v0[i].w * v0[i].w;
      ss1 += v1[i].x * v1[i].x + v1[i].y * v1[i].y + v1[i].z * v1[i].z + v1[i].w * v1[i].w;
    }
#pragma unroll
    for (int o = 32; o >= 1; o >>= 1) { ss0 += __shfl_xor(ss0, o); ss1 += __shfl_xor(ss1, o); }
    const float r0 = rsqrtf(ss0 * (1.f / 1024.f) + EPSV), r1 = rsqrtf(ss1 * (1.f / 1024.f) + EPSV);
    float* y0 = p.out + OUT_Y + (size_t)row * DM;
    float* y1 = p.out + OUT_Y + (size_t)row1 * DM;
#pragma unroll
    for (int i = 0; i < 4; ++i) {
      const int col = i * 256 + lane * 4;
      { f32x4 ov = {v0[i].x * r0 * g[i].x, v0[i].y * r0 * g[i].y, v0[i].z * r0 * g[i].z, v0[i].w * r0 * g[i].w}; __builtin_nontemporal_store(ov, (f32x4*)(y0 + col)); }
      if (has1) { f32x4 ov = {v1[i].x * r1 * g[i].x, v1[i].y * r1 * g[i].y, v1[i].z * r1 * g[i].z, v1[i].w * r1 * g[i].w}; __builtin_nontemporal_store(ov, (f32x4*)(y1 + col)); }
    }
  }
}

extern __shared__ __attribute__((aligned(16))) unsigned char smem_dyn[];

__global__ void __launch_bounds__(512, 2) mega(Params p) {
  unsigned char* smem_all = smem_dyn;
  cg::grid_group grid = cg::this_grid();
  if (p.ws == nullptr) grid.sync();
  if (threadIdx.x == 0) *(uint4*)(smem_all + LDS_GEMM) = make_uint4(0u, 0u, 0u, 0u);
  __syncthreads();
  const XcdBarrier xb = xcd_barrier_post((unsigned*)(p.ws + OFF_BAR), (volatile LAS unsigned*)(smem_all + LDS_GEMM));
  const int nb = gridDim.x;
  const int half = __builtin_amdgcn_readfirstlane(threadIdx.x >> 8);
#define tid (opq(threadIdx.x) & 255)
  unsigned char* smem = smem_all + half * LDS_HALF;
  for (int t = blockIdx.x * 2 + half; t < 384 + 1; t += nb * 2) {
    if (t < 384) p0_adaln(p, t, smem, tid);
    else p0_rope(p, tid);
  }
  xcd_barrier(xb);
  for (int t = blockIdx.x * 2 + half; t < 768 + 256; t += nb * 2) {
    if (t < 768) p0_transpose(p.w_in, ZW, (u16*)(p.ws + OFF_WINT), t / 48, t % 48, smem, tid);
    else { int q = t - 768; p0_transpose(p.w_out, 1024, (u16*)(p.ws + OFF_WOUTT), q >> 4, q & 15, smem, tid); }
  }
  p1_rows(p);
  xcd_barrier(xb);
  {
    pg8::Gemm g; g.A = (const u16*)(p.ws + OFF_HY); g.Bt = (const u16*)(p.ws + OFF_WINT); g.M = T_TOK; g.N = ZWP; g.K = 1024;
    pg8::StaticOrder S; S.init(T_TOK, ZWP, nb, blockIdx.x);
    EpiZ E; E.ws = p.ws; E.outp = p.out;
    pg8::gemm_phase<EpiZ, pg8::StaticOrder, false>((PG8_LAS unsigned char*)smem_all, g, S, E, nullptr);
  }
  xcd_barrier(xb);
  for (int t = blockIdx.x * 2 + half; t < 1536 + 832; t += nb * 2) {
    if (t < 1536) gla_ds_task(p, t, smem, tid);
    else vt_task(p, t - 1536, smem, tid);
  }
  xcd_barrier(xb);
  {
    const bool scan_first = (blockIdx.x >> 3) & 1;
    for (int sp = 0; sp < 2; ++sp) {
      if ((sp == 0) == scan_first) {
        for (int t = blockIdx.x * 2 + half; t < 512; t += nb * 2) gla_scan_task(p, t, tid);
        for (int q = blockIdx.x * 2 + half; q < 1024; q += nb * 2) gla_scan_prompt4(p, q, tid);
      } else {
        for (int t = blockIdx.x * 2 + half; t < 1536; t += nb * 2) attn_item(p, t, smem, tid);
      }
    }
  }
  xcd_barrier(xb);
  for (int t = blockIdx.x * 2 + half; t < 1536; t += nb * 2) gla_out_task(p, t, smem, tid);
  xcd_barrier(xb);
  {
    pg8::Gemm g; g.A = (const u16*)(p.ws + OFF_HY); g.Bt = (const u16*)(p.ws + OFF_WOUTT); g.M = T_TOK; g.N = 1024; g.K = 1024;
    pg8::StaticOrder S; S.init(T_TOK, 1024, nb, blockIdx.x);
    EpiOut E; E.ws = p.ws; E.outp = p.out; E.xp = p.xp; E.xs = p.xs;
    pg8::gemm_phase<EpiOut, pg8::StaticOrder, false>((PG8_LAS unsigned char*)smem_all, g, S, E, nullptr);
  }
  xcd_barrier(xb);
  final_rows(p);
#undef tid
}

extern "C" void kernel_launch(void* const* d_in, const int* in_sizes, int n_in, void* d_out, int out_size,
                              void* d_ws, size_t ws_size, hipStream_t stream) {
  static int grid_blocks = 0;
  if (!grid_blocks) {
    int dev = 0, cus = 0, per_cu = 0;
    (void)hipGetDevice(&dev);
    (void)hipDeviceGetAttribute(&cus, hipDeviceAttributeMultiprocessorCount, dev);
    (void)hipFuncSetAttribute((const void*)mega, hipFuncAttributeMaxDynamicSharedMemorySize, LDS_TOTAL);
    (void)hipOccupancyMaxActiveBlocksPerMultiprocessor(&per_cu, mega, 512, LDS_TOTAL);
    if (per_cu < 1) per_cu = 1;
    grid_blocks = cus;
  }
  Params p{};
  const float** pp = (const float**)&p;
  for (int i = 0; i < 19; ++i) pp[i] = (const float*)d_in[i];
  p.out = (float*)d_out;
  p.ws = (unsigned char*)d_ws;
  (void)hipMemsetAsync((char*)d_ws + OFF_BAR, 0, XCD_BAR_WORDS * 4, stream);
  void* args[] = {&p};
  hipError_t e = hipLaunchCooperativeKernel((void*)mega, dim3(grid_blocks), dim3(512), args, LDS_TOTAL, stream);
  if (e != hipSuccess) fprintf(stderr, "cooperative launch failed: %s (grid %d)\n", hipGetErrorString(e), grid_blocks);
}
```

```cpp
#include <hip/hip_runtime.h>
#include <hip/hip_cooperative_groups.h>
#include <cstdio>
namespace cg = cooperative_groups;

typedef unsigned short u16;
using bf16x8 = __attribute__((ext_vector_type(8))) short;
using f32x4  = __attribute__((ext_vector_type(4))) float;
using f32x16 = __attribute__((ext_vector_type(16))) float;
using u32x4 = __attribute__((ext_vector_type(4))) unsigned;

#define T_TOK   24576
#define NP_TOK  8192
#define DM      1024
#define ZW      2848
#define ZWP     3072
#define EPSV    1e-6f

#define C_Q   0
#define C_K   512
#define C_V   640
#define C_ZA  768
#define C_QG  1280
#define C_KG  1536
#define C_VG  1792
#define C_LR  2304
#define C_ZG  2336

#define OFF_MOD   0ull
#define OFF_ROPE  65536ull
#define OFF_BAR   81920ull
#define OFF_DEC   131072ull
#define OFF_LR    1048576ull
#define OFF_WINT  4194304ull
#define OFF_WOUTT 10485760ull
#define OFF_HY    12582912ull
#define OFF_Z     62914560ull
#define OFF_SPT   202899456ull
#define OFF_VTG   253231104ull
#define OFF_KC    260046848ull
#define TTOT      26624

#define OUT_Y     0
#define OUT_NK    25165824
#define OUT_NV    26214400
#define OUT_NS    27262976

#define LDS_HALF  59392
#define LDS_GEMM  131072
#define LDS_TOTAL (LDS_GEMM + 16)

struct Params {
  const float *xp, *xs, *c, *cache_k, *cache_v, *state_gla, *c_ctx, *w_mod, *b_mod, *norm_g, *w_in,
              *w_gk_f, *b_gk_f, *w_gk_b, *b_gk_b, *sink, *gla_norm_g, *w_out, *final_norm_g;
  float* out;
  unsigned char* ws;
};

typedef __bf16 bf16v2_t __attribute__((ext_vector_type(2)));
typedef float f32v2_t __attribute__((ext_vector_type(2)));
__device__ __forceinline__ unsigned cvtpk(float lo, float hi) { f32v2_t f = {lo, hi}; bf16v2_t b = __builtin_convertvector(f, bf16v2_t); return __builtin_bit_cast(unsigned, b); }
__device__ __forceinline__ u16 f2bf(float f) { return (u16)(cvtpk(f, f) & 0xffffu); }
__device__ __forceinline__ float bf2f(u16 h) { return __uint_as_float(((unsigned)h) << 16); }
__device__ __forceinline__ unsigned pack2(float a, float b) { return cvtpk(a, b); }
__device__ __forceinline__ float bflo(unsigned u) { return __uint_as_float(u << 16); }
__device__ __forceinline__ float bfhi(unsigned u) { return __uint_as_float(u & 0xffff0000u); }
__device__ __forceinline__ float siluf(float x) { return x / (1.f + __expf(-x)); }
__device__ __forceinline__ float logsigf(float x) { return fminf(x, 0.f) - __logf(1.f + __expf(-fabsf(x))); }
using u32x2 = __attribute__((ext_vector_type(2))) unsigned;
__device__ __forceinline__ uint4 ldnt16(const void* p) { const u32x4 v = __builtin_nontemporal_load((const u32x4*)p); return make_uint4(v.x, v.y, v.z, v.w); }
__device__ __forceinline__ uint2 ldnt8(const void* p) { const u32x2 v = __builtin_nontemporal_load((const u32x2*)p); return make_uint2(v.x, v.y); }
__device__ __forceinline__ float4 ldnt16f(const float* p) { const f32x4 v = __builtin_nontemporal_load((const f32x4*)p); return make_float4(v[0], v[1], v[2], v[3]); }
__device__ __forceinline__ int opq(int v) { asm volatile("" : "+v"(v)); return v; }
__device__ __forceinline__ int rowmap(int reg, int hh) { return (reg & 3) + 8 * (reg >> 2) + 4 * hh; }

__device__ __forceinline__ f32x16 mfma32(bf16x8 a, bf16x8 b, f32x16 c) {
  return __builtin_amdgcn_mfma_f32_32x32x16_bf16(a, b, c, 0, 0, 0);
}
__device__ __forceinline__ f32x4 mfma16(bf16x8 a, bf16x8 b, f32x4 c) {
  return __builtin_amdgcn_mfma_f32_16x16x32_bf16(a, b, c, 0, 0, 0);
}
__device__ __forceinline__ const float* xrow_ptr(const Params& p, int t) {
  return (t < NP_TOK) ? (p.xp + (size_t)t * DM) : (p.xs + (size_t)(t - NP_TOK) * DM);
}
__device__ __forceinline__ int mod_idx(int t) { return (t < NP_TOK) ? 0 : 1 + ((t - NP_TOK) >> 12); }

__device__ const double kFreq[16] = {
  1.0, 0.5623413251903491, 0.31622776601683794, 0.1778279410038923, 0.1, 0.05623413251903491,
  0.03162277660168379, 0.01778279410038923, 0.01, 0.005623413251903491, 0.0031622776601683794,
  0.0017782794100389228, 0.001, 0.0005623413251903491, 0.00031622776601683794, 0.00017782794100389227};

#define XB_TMO      128
#define XB_XCNT(j)  (256  + 64 * (j))
#define XB_XSUB(j)  (1280 + 64 * (j))
#define XB_XGEN(j)  (2304 + 64 * (j))
#define XB_TOP      3328
#define XB_TOPGEN   3392
#define XCD_BAR_WORDS 3456
#define XB_SPIN_CAP (1u << 18)
#define LAS __attribute__((address_space(3)))

__device__ __forceinline__ unsigned xb_ld(unsigned* p)              { return __hip_atomic_load(p, __ATOMIC_RELAXED, __HIP_MEMORY_SCOPE_AGENT); }
__device__ __forceinline__ unsigned xb_add(unsigned* p, unsigned v) { return __hip_atomic_fetch_add(p, v, __ATOMIC_RELAXED, __HIP_MEMORY_SCOPE_AGENT); }
__device__ __forceinline__ unsigned xb_xcc_id() { return (unsigned)__builtin_amdgcn_s_getreg((3 << 11) | 20) & 0xFu; }
#define XB_SPIN(cond, bar) do { unsigned _sp = 0; while (cond) { __builtin_amdgcn_s_sleep(1); \
    if ((++_sp & 255u) == 0u) { if (xb_ld(&(bar)[XB_TMO])) break; if (_sp > XB_SPIN_CAP) { atomicAdd(&(bar)[XB_TMO], 1u); break; } } } } while (0)

struct XcdBarrier {
    unsigned* bar; unsigned x;
    volatile LAS unsigned* st;
};

__device__ __forceinline__ XcdBarrier xcd_barrier_post(unsigned* bar, volatile LAS unsigned* st) {
    XcdBarrier b; b.bar = bar; b.x = xb_xcc_id(); b.st = st;
    if (threadIdx.x == 0) (void)xb_add(&bar[XB_XCNT(b.x)], 1u);
    return b;
}
__device__ __forceinline__ void xcd_barrier_complete(unsigned* bar, unsigned x, unsigned& nloc, unsigned& nx) {
    const unsigned G = gridDim.x * gridDim.y * gridDim.z;
    unsigned sum, cnt, mine, sp = 0u;
    for (;;) {
        sum = 0u; cnt = 0u; mine = 0u;
#pragma unroll
        for (unsigned j = 0; j < 16; ++j) { const unsigned c = xb_ld(&bar[XB_XCNT(j)]); sum += c; cnt += (c > 0u) ? 1u : 0u; mine = (j == x) ? c : mine; }
        if (sum == G) break;
        __builtin_amdgcn_s_sleep(1);
        if ((++sp & 255u) == 0u) { if (xb_ld(&bar[XB_TMO])) break; if (sp > XB_SPIN_CAP) { atomicAdd(&bar[XB_TMO], 1u); break; } }
    }
    nloc = mine > 0u ? mine : 1u; nx = cnt > 0u ? cnt : 1u;
}

__device__ __forceinline__ void xcd_barrier(const XcdBarrier& b) {
    asm volatile("s_waitcnt vmcnt(0)" ::: "memory");
    __syncthreads();
    if (threadIdx.x == 0) {
        unsigned* bar = b.bar;
        __builtin_amdgcn_s_waitcnt(0);
        unsigned nloc = b.st[0], nx = b.st[1];
        if (nloc == 0u) { xcd_barrier_complete(bar, b.x, nloc, nx); b.st[0] = nloc; b.st[1] = nx; }
        const unsigned old = xb_add(&bar[XB_XSUB(b.x)], 1u);
        const unsigned gen = old / nloc;
        if (old + 1u == (gen + 1u) * nloc) {
            __builtin_amdgcn_fence(__ATOMIC_RELEASE, "agent");
            asm volatile("s_waitcnt vmcnt(0)" ::: "memory");
            const unsigned og = xb_add(&bar[XB_TOP], 1u);
            const unsigned tg = og / nx;
            if (og + 1u == (tg + 1u) * nx) xb_add(&bar[XB_TOPGEN], 1u);
            else XB_SPIN(xb_ld(&bar[XB_TOPGEN]) == tg, bar);
            __builtin_amdgcn_fence(__ATOMIC_ACQUIRE, "agent");
            xb_add(&bar[XB_XGEN(b.x)], 1u);
            asm volatile("s_waitcnt vmcnt(0)" ::: "memory");
        } else {
            XB_SPIN(xb_ld(&bar[XB_XGEN(b.x)]) == gen, bar);
            __builtin_amdgcn_fence(__ATOMIC_ACQUIRE, "agent");
            asm volatile("s_waitcnt vmcnt(0)" ::: "memory");
        }
    }
    __syncthreads();
}


__device__ void p0_adaln(const Params& p, int task, unsigned char* smem, const int tid) {
  float* sc  = (float*)smem;
  float* red = sc + 5120;
  float* MOD = (float*)(p.ws + OFF_MOD);
  const int rg = tid >> 1, qd = tid & 1;
  const int c0 = task * 8 + qd * 4;
  float4 wv[8];
#pragma unroll
  for (int it = 0; it < 8; ++it) wv[it] = ldnt16f(p.w_mod + (size_t)(it * 128 + rg) * 3072 + c0);
  for (int e = tid; e < 5120; e += 256) {
    int i = e >> 10, k = e & 1023;
    float v = (i == 0) ? p.c_ctx[k] : p.c[(i - 1) * 1024 + k];
    sc[e] = siluf(v);
  }
  __syncthreads();
  float acc[5][4];
#pragma unroll
  for (int i = 0; i < 5; ++i)
#pragma unroll
    for (int j = 0; j < 4; ++j) acc[i][j] = 0.f;
#pragma unroll
  for (int it = 0; it < 8; ++it) {
    const int row = it * 128 + rg;
#pragma unroll
    for (int i = 0; i < 5; ++i) {
      const float sv = sc[i * 1024 + row];
      acc[i][0] += sv * wv[it].x; acc[i][1] += sv * wv[it].y; acc[i][2] += sv * wv[it].z; acc[i][3] += sv * wv[it].w;
    }
  }
#pragma unroll
  for (int i = 0; i < 5; ++i)
#pragma unroll
    for (int j = 0; j < 4; ++j) red[rg * 40 + i * 8 + qd * 4 + j] = acc[i][j];
  __syncthreads();
  if (tid < 40) {
    const int i = tid >> 3, cc = tid & 7;
    float sum = 0.f;
    for (int r2 = 0; r2 < 128; ++r2) sum += red[r2 * 40 + tid];
    MOD[i * 3072 + task * 8 + cc] = sum + p.b_mod[task * 8 + cc];
  }
  __syncthreads();
}

__device__ void p0_transpose(const float* W, int N, u16* WT, int kt, int nt, unsigned char* smem, const int tid) {
  float* tile = (float*)smem;
  const int r = tid >> 4, c4 = (tid & 15) * 4;
  const int k0 = kt * 64, n0 = nt * 64;
#pragma unroll
  for (int it = 0; it < 4; ++it) {
    int row = r + 16 * it;
    float4 v = make_float4(0.f, 0.f, 0.f, 0.f);
    if (n0 + c4 < N) v = ldnt16f(W + (size_t)(k0 + row) * N + n0 + c4);
    tile[row * 65 + c4 + 0] = v.x; tile[row * 65 + c4 + 1] = v.y;
    tile[row * 65 + c4 + 2] = v.z; tile[row * 65 + c4 + 3] = v.w;
  }
  __syncthreads();
  const int n = tid >> 2, kq = (tid & 3) * 16;
  unsigned u[8];
#pragma unroll
  for (int j = 0; j < 8; ++j) u[j] = pack2(tile[(kq + 2 * j) * 65 + n], tile[(kq + 2 * j + 1) * 65 + n]);
  uint4* dst = (uint4*)(WT + (size_t)(n0 + n) * 1024 + k0 + kq);
  dst[0] = make_uint4(u[0], u[1], u[2], u[3]);
  dst[1] = make_uint4(u[4], u[5], u[6], u[7]);
  __syncthreads();
}

__device__ void p0_rope(const Params& p, const int tid) {
  float* ROPE = (float*)(p.ws + OFF_ROPE);
  if (tid < 16) {
    double f = kFreq[tid];
    double x2 = f * f, s = 1.0, c = 1.0;
    for (int n = 10; n >= 1; --n) {
      s = 1.0 - x2 / (double)((2 * n) * (2 * n + 1)) * s;
      c = 1.0 - x2 / (double)((2 * n - 1) * (2 * n)) * c;
    }
    s *= f;
    double cc = 1.0, ss = 0.0;
    for (int pos = 0; pos < 64; ++pos) {
      ROPE[pos * 16 + tid] = (float)cc;
      ROPE[1024 + pos * 16 + tid] = (float)ss;
      double nc = cc * c - ss * s, ns = ss * c + cc * s;
      cc = nc; ss = ns;
    }
  }
}

__device__ void p1_rows(const Params& p) {
  const float* MOD = (const float*)(p.ws + OFF_MOD);
  u16* H = (u16*)(p.ws + OFF_HY);
  const int thr = opq(threadIdx.x);
  const int lane = thr & 63, w = thr >> 6;
  float4 g[4];
#pragma unroll
  for (int i = 0; i < 4; ++i) g[i] = *(const float4*)(p.norm_g + i * 256 + lane * 4);
  const int stride = gridDim.x * 8;
  for (int row = blockIdx.x * 8 + w; row < T_TOK; row += 2 * stride) {
    const int row1 = row + stride;
    const bool has1 = row1 < T_TOK;
    const float* x0 = xrow_ptr(p, row);
    const float* x1 = xrow_ptr(p, has1 ? row1 : row);
    const float* md0 = MOD + mod_idx(row) * 3072;
    const float* md1 = MOD + mod_idx(has1 ? row1 : row) * 3072;
    float4 v0[4], v1[4], sh0[4], sc0[4], sh1[4], sc1[4];
#pragma unroll
    for (int i = 0; i < 4; ++i) {
      const f32x4 a = __builtin_nontemporal_load((const f32x4*)(x0 + i * 256 + lane * 4)), b2 = __builtin_nontemporal_load((const f32x4*)(x1 + i * 256 + lane * 4));
      v0[i] = make_float4(a[0], a[1], a[2], a[3]); v1[i] = make_float4(b2[0], b2[1], b2[2], b2[3]);
    }
#pragma unroll
    for (int i = 0; i < 4; ++i) {
      sh0[i] = *(const float4*)(md0 + i * 256 + lane * 4); sc0[i] = *(const float4*)(md0 + 1024 + i * 256 + lane * 4);
      sh1[i] = *(const float4*)(md1 + i * 256 + lane * 4); sc1[i] = *(const float4*)(md1 + 1024 + i * 256 + lane * 4);
    }
    float ss0 = 0.f, ss1 = 0.f;
#pragma unroll
    for (int i = 0; i < 4; ++i) {
      ss0 += v0[i].x * v0[i].x + v0[i].y * v0[i].y + v0[i].z * v0[i].z + v0[i].w * v0[i].w;
      ss1 += v1[i].x * v1[i].x + v1[i].y * v1[i].y + v1[i].z * v1[i].z + v1[i].w * v1[i].w;
    }
#pragma unroll
    for (int o = 32; o >= 1; o >>= 1) { ss0 += __shfl_xor(ss0, o); ss1 += __shfl_xor(ss1, o); }
    const float r0 = rsqrtf(ss0 * (1.f / 1024.f) + EPSV), r1 = rsqrtf(ss1 * (1.f / 1024.f) + EPSV);
#pragma unroll
    for (int i = 0; i < 4; ++i) {
      const int col = i * 256 + lane * 4;
      uint2 o2 = make_uint2(pack2(v0[i].x * r0 * g[i].x * (1.f + sc0[i].x) + sh0[i].x, v0[i].y * r0 * g[i].y * (1.f + sc0[i].y) + sh0[i].y),
                            pack2(v0[i].z * r0 * g[i].z * (1.f + sc0[i].z) + sh0[i].z, v0[i].w * r0 * g[i].w * (1.f + sc0[i].w) + sh0[i].w));
      *(uint2*)(H + (size_t)row * DM + col) = o2;
      if (has1) {
        uint2 o3 = make_uint2(pack2(v1[i].x * r1 * g[i].x * (1.f + sc1[i].x) + sh1[i].x, v1[i].y * r1 * g[i].y * (1.f + sc1[i].y) + sh1[i].y),
                              pack2(v1[i].z * r1 * g[i].z * (1.f + sc1[i].z) + sh1[i].z, v1[i].w * r1 * g[i].w * (1.f + sc1[i].w) + sh1[i].w));
        *(uint2*)(H + (size_t)row1 * DM + col) = o3;
      }
    }
  }
}

namespace pg8 {
#define PG8_LAS __attribute__((address_space(3)))
typedef unsigned short bf16_t;
typedef short bf16x8 __attribute__((ext_vector_type(8)));
typedef float f32x4 __attribute__((ext_vector_type(4)));
typedef unsigned u32x4 __attribute__((ext_vector_type(4)));
constexpr int BM = 256, BK = 64, HALF = 128, HTB = HALF * BK * 2  , STAGE_BYTES = 8 * HTB, NXCD = 8, WGM = 8;

__host__ __device__ __forceinline__ int lds_byte(int r, int c) { const int st = (r >> 4) * 2 + (c >> 5), rr = r & 15, cc = c & 31, ob = rr * 64 + cc * 2; return st * 1024 + (ob ^ (((ob >> 9) & 1) << 5)); }
__host__ __device__ __forceinline__ void stage_rc(int b, int& R, int& C) { const int st = b / 1024, sb = b % 1024, swz = sb ^ (((sb >> 9) & 1) << 5); R = (st >> 1) * 16 + swz / 64; C = (st & 1) * 32 + (swz % 64) / 2; }
__host__ __device__ __forceinline__ int perm32(int rho) { const int n = rho >> 4, i = rho & 15; return 8 * (i >> 2) + 4 * n + (i & 3); }

struct Unit { int pm, pn; };
struct Gemm { const bf16_t* A; const bf16_t* Bt; int M, N, K; };

struct StaticOrder {
    int nM, nN, nwg, G, c;
    __host__ __device__ void init(int M, int N, int G_, int c_) { nM = M / BM; nN = N / BM; nwg = nM * nN; G = G_; c = c_; }
    __host__ __device__ bool next(int i, Unit& u) const {
        const long L = (long)i * G + c; if (L >= nwg) return false;
        int wgid = (int)L; { const int q = nwg / NXCD, r = nwg % NXCD, xcd = wgid % NXCD, off = wgid / NXCD; wgid = (xcd < r ? xcd * (q + 1) : r * (q + 1) + (xcd - r) * q) + off; }
        const int nig = WGM * nN, gid = wgid / nig, fm = gid * WGM, gsz = (nM - fm) < WGM ? (nM - fm) : WGM;
        u.pm = fm + ((wgid % nig) % gsz); u.pn = (wgid % nig) / gsz; return true;
    }
    __device__ __forceinline__ void a_ready(const Unit&) const {}
    __device__ __forceinline__ void done(const Unit&) const {}
};
__device__ __forceinline__ unsigned cvt_pk_bf16(float lo, float hi) { unsigned r; asm volatile("v_cvt_pk_bf16_f32 %0, %1, %2" : "=v"(r) : "v"(lo), "v"(hi)); return r; }
template <class Epi, class Sched, bool STAMP = false>
__device__ __forceinline__ void gemm_phase(PG8_LAS unsigned char* lds, const Gemm g, const Sched& S, const Epi& E, unsigned long long* stamps) {
    int tid_ = threadIdx.x; asm volatile("" : "+v"(tid_));
    const int tid = tid_, wid = __builtin_amdgcn_readfirstlane(tid >> 6), lane = tid & 63, wr = wid >> 2, wc = wid & 3, fr = lane & 15, fq = lane >> 4;
    const int K = g.K, nt = K / BK;
    int ts_lo = 0, ts_hi = 0, nts = 0; const unsigned long long rt_entry = STAMP ? (unsigned long long)wall_clock64() : 0ull;
#define PG8_STAMP() do { if (STAMP && wid == 0 && nts < 64) { const unsigned long long _c = (unsigned long long)clock64(); \
        ts_lo = (lane == nts) ? (int)(unsigned)_c : ts_lo; ts_hi = (lane == nts) ? (int)(unsigned)(_c >> 32) : ts_hi; ++nts; } } while (0)
    PG8_STAMP();
    unsigned voffA[2], voffB[2];
#pragma unroll
    for (int i = 0; i < 2; ++i) { int R, C; stage_rc(tid * 16 + i * 8192, R, C); const int Rb = Epi::PERM ? ((R & ~31) + perm32(R & 31)) : R;
        voffA[i] = (unsigned)(R * K + C) * 2u; voffB[i] = (unsigned)(Rb * K + C) * 2u; }
    const size_t kstep = (size_t)(BK * 2);
    const size_t hstep = (size_t)HALF * K * 2;
    const size_t tstep = 2 * hstep;
    const unsigned ldsw = (unsigned)wid * 1024u;
    const int aoff = lds_byte(wr * 64 + fr, fq * 8), boff = lds_byte(wc * 32 + fr, fq * 8);
#define PG8_SA(b, h) (((b) * 2 + (h)) * HTB)
#define PG8_SB(b, h) ((4 + (b) * 2 + (h)) * HTB)
#define PG8_STAGE(bufoff, gbase, voff) do { _Pragma("unroll") for (int _i = 0; _i < 2; ++_i) \
        __builtin_amdgcn_global_load_lds((const unsigned*)((const char*)(gbase) + (voff)[_i]), (PG8_LAS unsigned*)(lds + (bufoff) + ldsw + _i * 8192), 16, 0, 0); } while (0)
#define PG8_LDA(dst, b, h) do { _Pragma("unroll") for (int m = 0; m < 4; ++m) _Pragma("unroll") for (int k = 0; k < 2; ++k) dst[m][k] = *(const PG8_LAS bf16x8*)(lds + PG8_SA(b, h) + aoff + m * 2048 + k * 1024); } while (0)
#define PG8_LDB(dst, b, h) do { _Pragma("unroll") for (int n = 0; n < 2; ++n) _Pragma("unroll") for (int k = 0; k < 2; ++k) dst[n][k] = *(const PG8_LAS bf16x8*)(lds + PG8_SB(b, h) + boff + n * 2048 + k * 1024); } while (0)
#define PG8_MMA(ai, bj, At, Bt) do { __builtin_amdgcn_s_setprio(1); _Pragma("unroll") for (int m = 0; m < 4; ++m) _Pragma("unroll") for (int n = 0; n < 2; ++n) _Pragma("unroll") for (int k = 0; k < 2; ++k) \
        acc[ai][bj][m][n] = __builtin_amdgcn_mfma_f32_16x16x32_bf16(Bt[n][k], At[m][k], acc[ai][bj][m][n], 0, 0, 0); __builtin_amdgcn_s_setprio(0); } while (0)
#define PG8_WAIT_V(n) asm volatile("s_waitcnt vmcnt(" #n ")" ::: "memory")
#define PG8_WAIT_L(n) asm volatile("s_waitcnt lgkmcnt(" #n ")" ::: "memory")
#define PG8_BAR __builtin_amdgcn_s_barrier()
#define PG8_SCHED __builtin_amdgcn_sched_barrier(0)
    Unit cur, nxt; int ui = 0;
    if (!S.next(0, cur)) return;
    f32x4 acc[2][2][4][2];
#pragma unroll
    for (int a = 0; a < 2; ++a)
#pragma unroll
        for (int b = 0; b < 2; ++b)
#pragma unroll
            for (int m = 0; m < 4; ++m)
#pragma unroll
                for (int n = 0; n < 2; ++n) acc[a][b][m][n] = (f32x4){0.f, 0.f, 0.f, 0.f};
    bf16x8 At[4][2], B0[2][2], B1[2][2];
    const char* cA = (const char*)g.A + (size_t)cur.pm * tstep; const char* cB = (const char*)g.Bt + (size_t)cur.pn * tstep;
    S.a_ready(cur);
    PG8_STAGE(PG8_SB(0, 0), cB, voffB); PG8_STAGE(PG8_SA(0, 0), cA, voffA); PG8_STAGE(PG8_SB(0, 1), cB + hstep, voffB); PG8_STAGE(PG8_SA(0, 1), cA + hstep, voffA);
    if (wr == 1) PG8_BAR;
    PG8_WAIT_V(4); PG8_BAR;
    PG8_STAGE(PG8_SB(1, 0), cB + kstep, voffB); PG8_STAGE(PG8_SA(1, 0), cA + kstep, voffA); PG8_STAGE(PG8_SB(1, 1), cB + hstep + kstep, voffB);
    PG8_WAIT_V(6); PG8_BAR;
    PG8_STAMP();
    for (;;) {
        const bool has_next = S.next(ui + 1, nxt);
        const char* nA = has_next ? (const char*)g.A + (size_t)nxt.pm * tstep : cA; const char* nB = has_next ? (const char*)g.Bt + (size_t)nxt.pn * tstep : cB;
        for (int t = 0; t < nt; t += 2) {
            const bool last = (t == nt - 2);
            const char* a1 = cA + (size_t)(t + 1) * kstep;
            const char* a2 = last ? nA : cA + (size_t)(t + 2) * kstep; const char* b2 = last ? nB : cB + (size_t)(t + 2) * kstep;
            const char* a3 = a2 + kstep; const char* b3 = b2 + kstep;
            if (last && has_next) S.a_ready(nxt);
            PG8_LDB(B0, 0, 0); PG8_SCHED; PG8_LDA(At, 0, 0); PG8_STAGE(PG8_SA(1, 1), a1 + hstep, voffA);
            PG8_WAIT_L(8); PG8_BAR; PG8_WAIT_L(0); PG8_MMA(0, 0, At, B0); PG8_BAR; PG8_SCHED;
            PG8_LDB(B1, 0, 1); PG8_STAGE(PG8_SB(0, 0), b2, voffB);
            PG8_BAR; PG8_WAIT_L(0); PG8_MMA(0, 1, At, B1); PG8_BAR;
            PG8_LDA(At, 0, 1); PG8_STAGE(PG8_SA(0, 0), a2, voffA);
            PG8_BAR; PG8_WAIT_L(0); PG8_MMA(1, 0, At, B0); PG8_BAR; PG8_SCHED;
            PG8_STAGE(PG8_SB(0, 1), b2 + hstep, voffB);
            PG8_WAIT_V(6); PG8_BAR; PG8_MMA(1, 1, At, B1); PG8_BAR;
            PG8_LDB(B0, 1, 0); PG8_SCHED; PG8_LDA(At, 1, 0); PG8_STAGE(PG8_SA(0, 1), a2 + hstep, voffA);
            PG8_WAIT_L(8); PG8_BAR; PG8_WAIT_L(0); PG8_MMA(0, 0, At, B0); PG8_BAR; PG8_SCHED;
            PG8_LDB(B1, 1, 1); PG8_STAGE(PG8_SB(1, 0), b3, voffB);
            PG8_BAR; PG8_WAIT_L(0); PG8_MMA(0, 1, At, B1); PG8_BAR;
            PG8_LDA(At, 1, 1); PG8_STAGE(PG8_SA(1, 0), a3, voffA);
            PG8_BAR; PG8_WAIT_L(0); PG8_MMA(1, 0, At, B0); PG8_BAR; PG8_SCHED;
            PG8_STAGE(PG8_SB(1, 1), b3 + hstep, voffB);
            PG8_WAIT_V(6); PG8_BAR; PG8_MMA(1, 1, At, B1); PG8_BAR;
        }
        PG8_STAMP();
        if constexpr (!Epi::AFTER_DRAIN) { E(acc, cur, wr, wc, fr, fq); S.done(cur); }
        PG8_STAMP();
        if (!has_next) break;
#pragma unroll
        for (int a = 0; a < 2; ++a)
#pragma unroll
            for (int b = 0; b < 2; ++b)
#pragma unroll
                for (int m = 0; m < 4; ++m)
#pragma unroll
                    for (int n = 0; n < 2; ++n) acc[a][b][m][n] = (f32x4){0.f, 0.f, 0.f, 0.f};
        cur = nxt; cA = nA; cB = nB; ++ui;
    }
    PG8_WAIT_V(0);
    if (wr == 0) PG8_BAR;
    PG8_BAR;
    if constexpr (Epi::AFTER_DRAIN) { E.fused(acc, cur, wr, wc, fr, fq, lds, wid, lane); S.done(cur); }
    PG8_STAMP();
    if (STAMP && wid == 0) { stamps[lane] = lane < nts ? (((unsigned long long)(unsigned)ts_hi << 32) | (unsigned)ts_lo) : 0ull;
        if (lane == 62) stamps[62] = rt_entry; if (lane == 63) stamps[63] = (unsigned long long)wall_clock64(); }
#undef PG8_STAMP
#undef PG8_SA
#undef PG8_SB
#undef PG8_STAGE
#undef PG8_LDA
#undef PG8_LDB
#undef PG8_MMA
#undef PG8_WAIT_V
#undef PG8_WAIT_L
#undef PG8_BAR
#undef PG8_SCHED
}
}

struct EpiZ {
  static constexpr bool PERM = true, AFTER_DRAIN = false;
  unsigned char* ws; float* outp;
  __device__ __forceinline__ void operator()(const pg8::f32x4 (&accin)[2][2][4][2], const pg8::Unit& u, int wr, int wc, int fr, int fq) const {
    u16* Z = (u16*)(ws + OFF_Z);
    float* LR = (float*)(ws + OFF_LR);
    const float* ROPE = (const float*)(ws + OFF_ROPE);
    const bool is_sample = (u.pm * 256) >= NP_TOK;
    const bool upper = fq >= 2;
#pragma unroll
    for (int ai = 0; ai < 2; ++ai)
#pragma unroll
      for (int m = 0; m < 4; ++m) {
        const int row = u.pm * 256 + ai * 128 + wr * 64 + m * 16 + fr;
#pragma unroll
        for (int bj = 0; bj < 2; ++bj) {
          pg8::f32x4 v0 = accin[ai][bj][m][0], v1 = accin[ai][bj][m][1];
          const int cb = u.pn * 256 + bj * 128 + wc * 32 + 8 * fq;
          if (is_sample && (u.pn < 2 || (u.pn == 2 && bj == 0))) {
            const int pos = (row - NP_TOK) & 4095;
            const int pp = (wc & 1) ? (pos & 63) : (pos >> 6);
            const float* tb = ROPE + pp * 16 + 8 * (fq & 1);
            const pg8::f32x4 c0 = *(const pg8::f32x4*)(tb), c1 = *(const pg8::f32x4*)(tb + 4);
            const pg8::f32x4 s0 = *(const pg8::f32x4*)(tb + 1024), s1 = *(const pg8::f32x4*)(tb + 1028);
#pragma unroll
            for (int j = 0; j < 4; ++j) {
              auto r0 = __builtin_amdgcn_permlane32_swap(__float_as_uint(v0[j]), __float_as_uint(v0[j]), false, false);
              const float a1 = __uint_as_float(r0[0]), a2 = __uint_as_float(r0[1]);
              v0[j] = upper ? (a2 * c0[j] + a1 * s0[j]) : (a1 * c0[j] - a2 * s0[j]);
              auto r1 = __builtin_amdgcn_permlane32_swap(__float_as_uint(v1[j]), __float_as_uint(v1[j]), false, false);
              const float b1 = __uint_as_float(r1[0]), b2 = __uint_as_float(r1[1]);
              v1[j] = upper ? (b2 * c1[j] + b1 * s1[j]) : (b1 * c1[j] - b2 * s1[j]);
            }
          }
          if (cb < ZW) *(uint4*)(Z + (size_t)row * ZW + cb) = make_uint4(cvtpk(v0[0], v0[1]), cvtpk(v0[2], v0[3]), cvtpk(v1[0], v1[1]), cvtpk(v1[2], v1[3]));
          if (!is_sample && u.pn == 2) {
            float* dst = (bj == 0) ? (outp + OUT_NK + (size_t)row * 128 + (cb - C_K)) : (outp + OUT_NV + (size_t)row * 128 + (cb - C_V));
            *(pg8::f32x4*)dst = v0; *(pg8::f32x4*)(dst + 4) = v1;
          }
          if (u.pn == 9 && cb < C_ZG) { float* dst = LR + (size_t)row * 32 + (cb - C_LR); *(pg8::f32x4*)dst = v0; *(pg8::f32x4*)(dst + 4) = v1; }
        }
      }
  }
};
struct EpiOut {
  static constexpr bool PERM = true, AFTER_DRAIN = false;
  unsigned char* ws; float* outp; const float* xp; const float* xs;
  __device__ __forceinline__ void operator()(const pg8::f32x4 (&accin)[2][2][4][2], const pg8::Unit& u, int wr, int wc, int fr, int fq) const {
    const float* MOD = (const float*)(ws + OFF_MOD);
    const float* gate = MOD + mod_idx(u.pm * 256) * 3072 + 2048;
    const int cb0 = u.pn * 256 + wc * 32 + 8 * fq;
    pg8::f32x4 gv[2][2];
#pragma unroll
    for (int bj = 0; bj < 2; ++bj) { gv[bj][0] = *(const pg8::f32x4*)(gate + cb0 + bj * 128); gv[bj][1] = *(const pg8::f32x4*)(gate + cb0 + bj * 128 + 4); }
#pragma unroll
    for (int ai = 0; ai < 2; ++ai)
#pragma unroll
      for (int m = 0; m < 4; ++m) {
        const int row = u.pm * 256 + ai * 128 + wr * 64 + m * 16 + fr;
        const float* xr = (row < NP_TOK) ? (xp + (size_t)row * DM) : (xs + (size_t)(row - NP_TOK) * DM);
        u16* orow = (u16*)(ws + OFF_Z) + (size_t)row * DM;
#pragma unroll
        for (int bj = 0; bj < 2; ++bj) {
          const int c = cb0 + bj * 128;
          const pg8::f32x4 x0 = __builtin_nontemporal_load((const pg8::f32x4*)(xr + c)), x1 = __builtin_nontemporal_load((const pg8::f32x4*)(xr + c + 4));
          const pg8::f32x4 o0 = x0 + gv[bj][0] * accin[ai][bj][m][0], o1 = x1 + gv[bj][1] * accin[ai][bj][m][1];
          *(uint4*)(orow + c) = make_uint4(cvtpk(o0[0], o0[1]), cvtpk(o0[2], o0[3]), cvtpk(o1[0], o1[1]), cvtpk(o1[2], o1[3]));
        }
      }
  }
};

__device__ void vt_task(const Params& p, int task, unsigned char* smem, const int tid) {
  u16* T = (u16*)smem;
  const u16* Z = (const u16*)(p.ws + OFF_Z);
  u16* VT = (u16*)(p.ws + OFF_VTG);
  u16* KC = (u16*)(p.ws + OFF_KC);
  const int chunk = task >> 1, kvh = task & 1;
  const int tok = tid >> 2, c = tid & 3;
  if (chunk < 384) {
    const uint4* src = (const uint4*)(Z + (size_t)(chunk * 64 + tok) * ZW + C_V + kvh * 64 + c * 16);
    const uint4 a0 = src[0], a1 = src[1];
    *(uint4*)&T[tok * 72 + c * 16] = a0;
    *(uint4*)&T[tok * 72 + c * 16 + 8] = a1;
  } else {
    const size_t off = ((size_t)((chunk - 384) * 64 + tok) * 2 + kvh) * 64 + c * 16;
    const float4* vs = (const float4*)(p.cache_v + off);
    const float4* ks = (const float4*)(p.cache_k + off);
    const float4 v0 = vs[0], v1 = vs[1], v2 = vs[2], v3 = vs[3];
    const float4 k0 = ks[0], k1 = ks[1], k2 = ks[2], k3 = ks[3];
    *(uint4*)&T[tok * 72 + c * 16] = make_uint4(pack2(v0.x, v0.y), pack2(v0.z, v0.w), pack2(v1.x, v1.y), pack2(v1.z, v1.w));
    *(uint4*)&T[tok * 72 + c * 16 + 8] = make_uint4(pack2(v2.x, v2.y), pack2(v2.z, v2.w), pack2(v3.x, v3.y), pack2(v3.z, v3.w));
    uint4* kd = (uint4*)(KC + off);
    kd[0] = make_uint4(pack2(k0.x, k0.y), pack2(k0.z, k0.w), pack2(k1.x, k1.y), pack2(k1.z, k1.w));
    kd[1] = make_uint4(pack2(k2.x, k2.y), pack2(k2.z, k2.w), pack2(k3.x, k3.y), pack2(k3.z, k3.w));
  }
  __syncthreads();
  {
    const int d = tid >> 2;
    unsigned o[8];
#pragma unroll
    for (int j = 0; j < 8; ++j) {
      const int p0 = 2 * j, p1 = 2 * j + 1;
      const int k0 = (p0 & 3) | ((p0 & 4) << 1) | ((p0 & 8) >> 1);
      const int k1 = (p1 & 3) | ((p1 & 4) << 1) | ((p1 & 8) >> 1);
      o[j] = (unsigned)T[(c * 16 + k0) * 72 + d] | ((unsigned)T[(c * 16 + k1) * 72 + d] << 16);
    }
    uint4* dst = (uint4*)(VT + (size_t)(kvh * 64 + d) * TTOT + chunk * 64 + c * 16);
    dst[0] = make_uint4(o[0], o[1], o[2], o[3]);
    dst[1] = make_uint4(o[4], o[5], o[6], o[7]);
  }
  __syncthreads();
}

struct TInfo { bool from_cache, masked, allmask; int kbase; };
__device__ __forceinline__ TInfo tile_info(bool latent, int qb, int ti) {
  TInfo t; t.from_cache = false; t.masked = false; t.allmask = false; t.kbase = 0;
  if (latent) {
    if (ti < 6) {
      t.kbase = (qb - 1) * 128 + ti * 64; t.masked = true;
      if (t.kbase < 0 || t.kbase >= 4096) { t.allmask = true; t.kbase = 0; }
    } else { t.from_cache = true; t.kbase = (ti - 6) * 64; }
  } else t.kbase = ti * 64;
  return t;
}
__device__ __forceinline__ float u2f(unsigned u) { return __uint_as_float(u); }

__device__ void attn_item(const Params& p, int item, unsigned char* smem, const int tid) {
  const u16* Z = (const u16*)(p.ws + OFF_Z);
  u16* Y = (u16*)(p.ws + OFF_HY);
  const int lane = tid & 63, w = __builtin_amdgcn_readfirstlane(tid >> 6), r = lane & 31, hh = lane >> 5;
  const bool latent = item < 1024;
  int b, kvh, g, qb, seq0;
  if (latent) { g = item & 3; qb = (item >> 2) & 31; kvh = (item >> 7) & 1; b = item >> 8; seq0 = NP_TOK + b * 4096; }
  else { int it = item - 1024; g = it & 3; qb = (it >> 2) & 1; kvh = (it >> 3) & 1; b = it >> 4; seq0 = b * 256; }
  const int h = kvh * 4 + g;
  const int t0 = seq0 + qb * 128;
  bf16x8 qf[4];
  {
    const u16* qptr = Z + (size_t)(t0 + w * 32 + r) * ZW + C_Q + h * 64 + hh * 8;
#pragma unroll
    for (int ks = 0; ks < 4; ++ks) qf[ks] = *(const bf16x8*)(qptr + ks * 16);
  }
  float m = p.sink[h] * 1.4426950408889634f, l = 1.f;
  f32x16 O0, O1;
#pragma unroll
  for (int i = 0; i < 16; ++i) { O0[i] = 0.f; O1[i] = 0.f; }
  const int ntiles = latent ? 14 : 4;
  const int qpos = qb * 128 + w * 32 + r;
  const int key = tid >> 2, dq = (tid & 3) * 16;
  const u16* VT = (const u16*)(p.ws + OFF_VTG);
  const u16* KC = (const u16*)(p.ws + OFF_KC);
  uint4 r0, r1, r2, r3;
  r0 = r1 = r2 = r3 = make_uint4(0u, 0u, 0u, 0u);
#define ATT_LOAD(ti_)                                                                                  \
  {                                                                                                    \
    const TInfo tt = tile_info(latent, qb, (ti_));                                                     \
    const u16* ksrc = tt.from_cache ? (KC + ((size_t)(b * 512 + tt.kbase + key) * 2 + kvh) * 64 + dq)   \
                                    : (Z + (size_t)(seq0 + tt.kbase + key) * ZW + C_K + kvh * 64 + dq); \
    const int slot = tt.from_cache ? (T_TOK + b * 512 + tt.kbase) : (seq0 + tt.kbase);                 \
    const u16* vsrc = VT + (size_t)(kvh * 64 + key) * TTOT + slot + dq;                                \
    r0 = *(const uint4*)(ksrc); r1 = *(const uint4*)(ksrc + 8);                                        \
    r2 = *(const uint4*)(vsrc); r3 = *(const uint4*)(vsrc + 8);                                        \
  }
#define ATT_STORE(ti_, buf_)                                                                           \
  {                                                                                                    \
    u16* Ksw = (u16*)(smem + (buf_) * 18432);                                                          \
    u16* Vtw = Ksw + 64 * 72;                                                                          \
    *(uint4*)&Ksw[key * 72 + dq] = r0;                                                                 \
    *(uint4*)&Ksw[key * 72 + dq + 8] = r1;                                                             \
    *(uint4*)&Vtw[key * 72 + dq] = r2;                                                                 \
    *(uint4*)&Vtw[key * 72 + dq + 8] = r3;                                                             \
  }
  ATT_LOAD(0)
  ATT_STORE(0, 0)
  ATT_LOAD(1)
  __syncthreads();
  for (int ti = 0; ti < ntiles; ++ti) {
    const TInfo tc = tile_info(latent, qb, ti);
    const u16* Ks = (const u16*)(smem + (ti & 1) * 18432);
    const u16* Vt = Ks + 64 * 72;
    f32x16 S[2];
#pragma unroll
    for (int mb = 0; mb < 2; ++mb) {
#pragma unroll
      for (int i = 0; i < 16; ++i) S[mb][i] = 0.f;
#pragma unroll
      for (int ks = 0; ks < 4; ++ks) {
        bf16x8 a = *(const bf16x8*)&Ks[(mb * 32 + r) * 72 + ks * 16 + hh * 8];
        S[mb] = mfma32(a, qf[ks], S[mb]);
      }
    }
    const int q0w = qb * 128 + w * 32;
    const bool need_mask = tc.masked && (tc.allmask || (q0w + 31 - tc.kbase > 128) || (tc.kbase + 63 - q0w > 128));
    float mx = -3.0e38f;
    if (need_mask) {
#pragma unroll
      for (int mb = 0; mb < 2; ++mb)
#pragma unroll
        for (int i = 0; i < 16; ++i) {
          float sv = S[mb][i];
          int kpos = tc.kbase + mb * 32 + rowmap(i, hh);
          int d = qpos - kpos;
          if (d > 128 || d < -128 || tc.allmask) sv = -1e30f;
          S[mb][i] = sv;
          mx = fmaxf(mx, sv);
        }
    } else {
#pragma unroll
      for (int mb = 0; mb < 2; ++mb)
#pragma unroll
        for (int i = 0; i < 16; ++i) mx = fmaxf(mx, S[mb][i]);
    }
    mx = fmaxf(mx, __shfl_xor(mx, 32)) * 0.18033688011112042f;
    const float mnew = fmaxf(m, mx);
    if (__builtin_amdgcn_ballot_w64(mx > m + 8.0f) != 0ull) {
      const float alpha = __builtin_amdgcn_exp2f(m - mnew);
      l *= alpha;
#pragma unroll
      for (int i = 0; i < 16; ++i) { O0[i] *= alpha; O1[i] *= alpha; }
      m = mnew;
    }
    float rs = 0.f;
#pragma unroll
    for (int mb = 0; mb < 2; ++mb)
#pragma unroll
      for (int i = 0; i < 16; ++i) {
        float pv = __builtin_amdgcn_exp2f(fmaf(S[mb][i], 0.18033688011112042f, -m));
        S[mb][i] = pv;
        rs += pv;
      }
    rs += __shfl_xor(rs, 32);
    l += rs;
#pragma unroll
    for (int mb = 0; mb < 2; ++mb)
#pragma unroll
      for (int s2 = 0; s2 < 2; ++s2) {
        u32x4 pku;
        pku.x = pack2(S[mb][8 * s2 + 0], S[mb][8 * s2 + 1]);
        pku.y = pack2(S[mb][8 * s2 + 2], S[mb][8 * s2 + 3]);
        pku.z = pack2(S[mb][8 * s2 + 4], S[mb][8 * s2 + 5]);
        pku.w = pack2(S[mb][8 * s2 + 6], S[mb][8 * s2 + 7]);
        const bf16x8 pkv = __builtin_bit_cast(bf16x8, pku);
        const int kk = mb * 32 + 16 * s2 + 8 * hh;
        O0 = mfma32(*(const bf16x8*)&Vt[r * 72 + kk], pkv, O0);
        O1 = mfma32(*(const bf16x8*)&Vt[(32 + r) * 72 + kk], pkv, O1);
      }
    if (ti + 1 < ntiles) ATT_STORE(ti + 1, (ti + 1) & 1)
    if (ti + 2 < ntiles) ATT_LOAD(ti + 2)
    __syncthreads();
  }
  const float inv = 1.f / l;
  float* Ow = (float*)smem + w * 32 * 68;
#pragma unroll
  for (int g4 = 0; g4 < 4; ++g4) {
    *(float4*)&Ow[r * 68 + 8 * g4 + 4 * hh] = make_float4(O0[4 * g4 + 0] * inv, O0[4 * g4 + 1] * inv, O0[4 * g4 + 2] * inv, O0[4 * g4 + 3] * inv);
    *(float4*)&Ow[r * 68 + 32 + 8 * g4 + 4 * hh] = make_float4(O1[4 * g4 + 0] * inv, O1[4 * g4 + 1] * inv, O1[4 * g4 + 2] * inv, O1[4 * g4 + 3] * inv);
  }
  __syncthreads();
#pragma unroll
  for (int i = 0; i < 4; ++i) {
    int idx = lane + 64 * i;
    int row = idx >> 3, c8 = (idx & 7) * 8;
    int t = t0 + w * 32 + row;
    float4 o0 = *(const float4*)&Ow[row * 68 + c8];
    float4 o1 = *(const float4*)&Ow[row * 68 + c8 + 4];
    uint4 za = ldnt16(Z + (size_t)t * ZW + C_ZA + h * 64 + c8);
    uint4 yo;
    yo.x = pack2(o0.x * siluf(bflo(za.x)), o0.y * siluf(bfhi(za.x)));
    yo.y = pack2(o0.z * siluf(bflo(za.y)), o0.w * siluf(bfhi(za.y)));
    yo.z = pack2(o1.x * siluf(bflo(za.z)), o1.y * siluf(bfhi(za.z)));
    yo.w = pack2(o1.z * siluf(bflo(za.w)), o1.w * siluf(bfhi(za.w)));
    *(uint4*)(Y + (size_t)t * DM + h * 64 + c8) = yo;
  }
  __syncthreads();
#undef ATT_LOAD
#undef ATT_STORE
}

__device__ __forceinline__ void gla_gates(const Params& p, int t0, int h, unsigned char* smem, float* part, float (&gcf)[16],
                                          float (&gcb)[16], float& gtf, float& gtb, const int tid) {
  const int dk = tid & 63, tq = tid >> 6;
  const float* LR = (const float*)(p.ws + OFF_LR);
  float* pre = (float*)smem;
  {
    const int lane = tid & 63, w = tid >> 6, r = lane & 31, hh = lane >> 5;
    const int dir = w & 1, nbk = w >> 1;
    const float* Wg = (dir ? p.w_gk_b : p.w_gk_f) + h * 64 + nbk * 32 + r;
    float wv[8];
#pragma unroll
    for (int j = 0; j < 8; ++j) wv[j] = Wg[(8 * hh + j) * 256];
    u32x4 bh, bl;
    {
      unsigned h0 = cvtpk(wv[0], wv[1]), h1 = cvtpk(wv[2], wv[3]), h2 = cvtpk(wv[4], wv[5]), h3 = cvtpk(wv[6], wv[7]);
      bh.x = h0; bh.y = h1; bh.z = h2; bh.w = h3;
      bl.x = cvtpk(wv[0] - bflo(h0), wv[1] - bfhi(h0)); bl.y = cvtpk(wv[2] - bflo(h1), wv[3] - bfhi(h1));
      bl.z = cvtpk(wv[4] - bflo(h2), wv[5] - bfhi(h2)); bl.w = cvtpk(wv[6] - bflo(h3), wv[7] - bfhi(h3));
    }
#pragma unroll
    for (int mb = 0; mb < 2; ++mb) {
      const float4* lp = (const float4*)(LR + (size_t)(t0 + mb * 32 + r) * 32 + dir * 16 + 8 * hh);
      const float4 x0 = lp[0], x1 = lp[1];
      u32x4 ah, al;
      ah.x = cvtpk(x0.x, x0.y); ah.y = cvtpk(x0.z, x0.w); ah.z = cvtpk(x1.x, x1.y); ah.w = cvtpk(x1.z, x1.w);
      al.x = cvtpk(x0.x - bflo(ah.x), x0.y - bfhi(ah.x)); al.y = cvtpk(x0.z - bflo(ah.y), x0.w - bfhi(ah.y));
      al.z = cvtpk(x1.x - bflo(ah.z), x1.y - bfhi(ah.z)); al.w = cvtpk(x1.z - bflo(ah.w), x1.w - bfhi(ah.w));
      f32x16 acc;
#pragma unroll
      for (int i = 0; i < 16; ++i) acc[i] = 0.f;
      acc = mfma32(__builtin_bit_cast(bf16x8, al), __builtin_bit_cast(bf16x8, bh), acc);
      acc = mfma32(__builtin_bit_cast(bf16x8, ah), __builtin_bit_cast(bf16x8, bl), acc);
      acc = mfma32(__builtin_bit_cast(bf16x8, ah), __builtin_bit_cast(bf16x8, bh), acc);
#pragma unroll
      for (int i = 0; i < 16; ++i) pre[dir * 4096 + (mb * 32 + rowmap(i, hh)) * 64 + nbk * 32 + r] = acc[i];
    }
  }
  __syncthreads();
  const float bf = p.b_gk_f[h * 64 + dk], bb = p.b_gk_b[h * 64 + dk];
#pragma unroll
  for (int j = 0; j < 16; ++j) {
    gcf[j] = logsigf(pre[(tq * 16 + j) * 64 + dk] + bf) * 0.0625f;
    gcb[j] = logsigf(pre[4096 + (tq * 16 + j) * 64 + dk] + bb) * 0.0625f;
  }
#pragma unroll
  for (int j = 1; j < 16; ++j) gcf[j] += gcf[j - 1];
#pragma unroll
  for (int j = 14; j >= 0; --j) gcb[j] += gcb[j + 1];
  part[tq * 64 + dk] = gcf[15];
  part[(4 + tq) * 64 + dk] = gcb[0];
  __syncthreads();
  float offf = 0.f, offb = 0.f;
  gtf = 0.f; gtb = 0.f;
#pragma unroll
  for (int q = 0; q < 4; ++q) {
    float a = part[q * 64 + dk], bq = part[(4 + q) * 64 + dk];
    gtf += a; gtb += bq;
    if (q < tq) offf += a;
    if (q > tq) offb += bq;
  }
#pragma unroll
  for (int j = 0; j < 16; ++j) { gcf[j] += offf; gcb[j] += offb; }
}

struct VRegs { uint4 a, b, c, d; };
__device__ __forceinline__ VRegs load_v(const u16* Z, int t0, int h, const int tid) {
  const int tok = tid >> 2, dq = (tid & 3) * 32;
  const uint4* src = (const uint4*)(Z + (size_t)(t0 + tok) * ZW + C_VG + h * 128 + dq);
  VRegs v; v.a = src[0]; v.b = src[1]; v.c = src[2]; v.d = src[3];
  return v;
}
__device__ __forceinline__ void store_vt(const VRegs& v, u16* Vt, const int tid) {
  const int tok = tid >> 2, dq = (tid & 3) * 32;
#define VTG(i, e, val) Vt[(dq + (i) * 8 + 2 * (e)) * 72 + tok] = (u16)((val) & 0xffffu); Vt[(dq + (i) * 8 + 2 * (e) + 1) * 72 + tok] = (u16)((val) >> 16);
  VTG(0, 0, v.a.x) VTG(0, 1, v.a.y) VTG(0, 2, v.a.z) VTG(0, 3, v.a.w)
  VTG(1, 0, v.b.x) VTG(1, 1, v.b.y) VTG(1, 2, v.b.z) VTG(1, 3, v.b.w)
  VTG(2, 0, v.c.x) VTG(2, 1, v.c.y) VTG(2, 2, v.c.z) VTG(2, 3, v.c.w)
  VTG(3, 0, v.d.x) VTG(3, 1, v.d.y) VTG(3, 2, v.d.z) VTG(3, 3, v.d.w)
#undef VTG
}

__device__ __forceinline__ int spt_off(int dv, int dk) { return (dv >> 5) * 2048 + (dk >> 4) * 512 + (dv & 31) * 16 + ((dk >> 3) & 1) * 8 + (dk & 7); }
__device__ void gla_ds_task(const Params& p, int task, unsigned char* smem, const int tid) {
  const int cgk = task >> 2, h = task & 3, t0 = cgk * 64;
  u16* KeF = (u16*)smem;
  u16* KeB = KeF + 64 * 72;
  u16* Vt = KeB + 64 * 72;
  float* part = (float*)(Vt + 128 * 72);
  const u16* Z = (const u16*)(p.ws + OFF_Z);
  u16* DSB = (u16*)(p.ws + OFF_SPT);
  float* DEC = (float*)(p.ws + OFF_DEC);
  const int lane = tid & 63, w = tid >> 6, r = lane & 31, hh = lane >> 5;
  const int dk = tid & 63, tq = tid >> 6;
  u16* RK = (u16*)(smem + 40960);
  {
    const uint4* ks_ = (const uint4*)(Z + (size_t)(t0 + (tid >> 2)) * ZW + C_KG + h * 64 + (tid & 3) * 16);
    const uint4 k0 = ks_[0], k1 = ks_[1];
    *(uint4*)&RK[(tid >> 2) * 72 + (tid & 3) * 16] = k0;
    *(uint4*)&RK[(tid >> 2) * 72 + (tid & 3) * 16 + 8] = k1;
  }
  const VRegs vr = load_v(Z, t0, h, tid);
  float gcf[16], gcb[16], gtf, gtb;
  gla_gates(p, t0, h, smem, part, gcf, gcb, gtf, gtb, tid);
  u16 kraw[16];
#pragma unroll
  for (int j = 0; j < 16; ++j) kraw[j] = RK[(tq * 16 + j) * 72 + dk];
  {
    unsigned kf[8], kb[8];
#pragma unroll
    for (int j = 0; j < 8; ++j) {
      const float k0 = bf2f(kraw[2 * j]), k1 = bf2f(kraw[2 * j + 1]);
      kf[j] = pack2(k0 * __expf(gtf - gcf[2 * j]), k1 * __expf(gtf - gcf[2 * j + 1]));
      kb[j] = pack2(k0 * __expf(gtb - gcb[2 * j]), k1 * __expf(gtb - gcb[2 * j + 1]));
    }
    *(uint4*)&KeF[dk * 72 + tq * 16] = make_uint4(kf[0], kf[1], kf[2], kf[3]);
    *(uint4*)&KeF[dk * 72 + tq * 16 + 8] = make_uint4(kf[4], kf[5], kf[6], kf[7]);
    *(uint4*)&KeB[dk * 72 + tq * 16] = make_uint4(kb[0], kb[1], kb[2], kb[3]);
    *(uint4*)&KeB[dk * 72 + tq * 16 + 8] = make_uint4(kb[4], kb[5], kb[6], kb[7]);
  }
  if (tq == 0) {
    DEC[(size_t)(task * 2 + 0) * 64 + dk] = __expf(gtf);
    DEC[(size_t)(task * 2 + 1) * 64 + dk] = __expf(gtb);
  }
  store_vt(vr, Vt, tid);
  __syncthreads();
  {
#pragma unroll
    for (int dir = 0; dir < 2; ++dir) {
      const u16* Ke = dir ? KeB : KeF;
#pragma unroll
      for (int nb2 = 0; nb2 < 2; ++nb2) {
        f32x16 acc;
#pragma unroll
        for (int i = 0; i < 16; ++i) acc[i] = 0.f;
#pragma unroll
        for (int ks = 0; ks < 4; ++ks) {
          bf16x8 a = *(const bf16x8*)&Ke[(nb2 * 32 + r) * 72 + ks * 16 + hh * 8];
          bf16x8 bq = *(const bf16x8*)&Vt[(w * 32 + r) * 72 + ks * 16 + hh * 8];
          acc = mfma32(a, bq, acc);
        }
        u16* dst = DSB + (size_t)(task * 2 + dir) * 8192 + w * 2048 + (nb2 * 2) * 512 + r * 16 + hh * 8;
#pragma unroll
        for (int k = 0; k < 4; k += 2) {
          unsigned ax = pack2(acc[4 * k + 0], acc[4 * k + 1]), ay = pack2(acc[4 * k + 2], acc[4 * k + 3]);
          unsigned bx = pack2(acc[4 * k + 4], acc[4 * k + 5]), by = pack2(acc[4 * k + 6], acc[4 * k + 7]);
          auto rx = __builtin_amdgcn_permlane32_swap(ax, bx, false, false);
          auto ry = __builtin_amdgcn_permlane32_swap(ay, by, false, false);
          *(uint4*)(dst + (k >> 1) * 512) = make_uint4(rx[0], ry[0], rx[1], ry[1]);
        }
      }
    }
  }
  __syncthreads();
}

__device__ void gla_scan_task(const Params& p, int task, const int tid) {
  const float* DEC = (const float*)(p.ws + OFF_DEC);
  u16* SPT = (u16*)(p.ws + OFF_SPT);
  const int chain = task >> 4, part = task & 15, b = chain >> 3, h = (chain >> 1) & 3, dir = chain & 1, cgbase = 128 + b * 64;
  const int e2 = part * 256 + tid;
  const int o2 = e2 * 2;
  const int dv = (o2 >> 11) * 32 + ((o2 >> 4) & 31), dk2 = ((o2 >> 9) & 3) * 16 + ((o2 >> 3) & 1) * 8 + (o2 & 7);
  const float* sg = p.state_gla + ((size_t)((b * 2 + dir) * 4 + h)) * 8192;
  float2 s = make_float2(sg[(dk2 + 0) * 128 + dv], sg[(dk2 + 1) * 128 + dv]);
  for (int i0 = 0; i0 < 64; i0 += 16) {
    unsigned du[16]; float2 dc[16];
#pragma unroll
    for (int j = 0; j < 16; ++j) {
      const int c = dir ? (63 - i0 - j) : (i0 + j);
      const size_t idx = (size_t)((cgbase + c) * 4 + h) * 2 + dir;
      du[j] = *(const unsigned*)(SPT + idx * 8192 + (size_t)e2 * 2);
      dc[j] = *(const float2*)(DEC + idx * 64 + dk2);
    }
#pragma unroll
    for (int j = 0; j < 16; ++j) {
      const int c = dir ? (63 - i0 - j) : (i0 + j);
      const size_t idx = (size_t)((cgbase + c) * 4 + h) * 2 + dir;
      *(unsigned*)(SPT + idx * 8192 + (size_t)e2 * 2) = pack2(s.x, s.y);
      s.x = dc[j].x * s.x + bflo(du[j]); s.y = dc[j].y * s.y + bfhi(du[j]);
    }
  }
}

__device__ void gla_scan_prompt4(const Params& p, int q, const int tid) {
  const float* DEC = (const float*)(p.ws + OFF_DEC);
  u16* SPT = (u16*)(p.ws + OFF_SPT);
  const int chain = q >> 2, b = chain >> 3, h = (chain >> 1) & 3, dir = chain & 1, cgbase = b * 4;
  const size_t sbase = ((size_t)((b * 2 + dir) * 4 + h)) * 8192;
  const int dv = (q & 3) * 32 + ((tid >> 3) & 31);
  const int dkl = ((tid >> 2) & 1) * 8 + (tid & 3) * 2;
  unsigned d[4][4]; float2 dc[4][4];
#pragma unroll
  for (int i = 0; i < 4; ++i) {
    const int c = dir ? (3 - i) : i;
    const size_t idx = (size_t)((cgbase + c) * 4 + h) * 2 + dir;
#pragma unroll
    for (int pp = 0; pp < 4; ++pp) {
      const int e2 = ((q & 3) * 4 + pp) * 256 + tid;
      d[pp][i] = *(const unsigned*)(SPT + idx * 8192 + (size_t)e2 * 2);
      dc[pp][i] = *(const float2*)(DEC + idx * 64 + pp * 16 + dkl);
    }
  }
#pragma unroll
  for (int pp = 0; pp < 4; ++pp) {
    const int e2 = ((q & 3) * 4 + pp) * 256 + tid;
    const int dk2 = pp * 16 + dkl;
    float2 sv = make_float2(0.f, 0.f);
#pragma unroll
    for (int i = 0; i < 4; ++i) {
      const int c = dir ? (3 - i) : i;
      const size_t idx = (size_t)((cgbase + c) * 4 + h) * 2 + dir;
      *(unsigned*)(SPT + idx * 8192 + (size_t)e2 * 2) = pack2(sv.x, sv.y);
      sv.x = dc[pp][i].x * sv.x + bflo(d[pp][i]); sv.y = dc[pp][i].y * sv.y + bfhi(d[pp][i]);
    }
    float* ns = p.out + OUT_NS + sbase;
    ns[(dk2 + 0) * 128 + dv] = sv.x; ns[(dk2 + 1) * 128 + dv] = sv.y;
  }
}

__device__ void gla_out_task(const Params& p, int task, unsigned char* smem, const int tid) {
  const int cgk = task >> 2, h = task & 3, t0 = cgk * 64;
  u16* QdF = (u16*)smem;
  u16* QdB = QdF + 64 * 72;
  u16* KiF = QdB + 64 * 72;
  u16* KiB = KiF + 64 * 72;
  u16* Vt = KiB + 64 * 72;
  float* part = (float*)(Vt + 128 * 72);
  float* ssq = part + 512;
  float* Os = (float*)smem;
  const u16* Z = (const u16*)(p.ws + OFF_Z);
  const u16* SPT = (const u16*)(p.ws + OFF_SPT);
  u16* Y = (u16*)(p.ws + OFF_HY);
  const int lane = tid & 63, w = tid >> 6, r = lane & 31, hh = lane >> 5;
  const int dk = tid & 63, tq = tid >> 6;
  u16* RQ = Vt;
  u16* RK = Vt + 64 * 72;
  {
    const u16* zr = Z + (size_t)(t0 + (tid >> 2)) * ZW + h * 64 + (tid & 3) * 16;
    const uint4 q0 = ldnt16(zr + C_QG), q1 = ldnt16(zr + C_QG + 8);
    const uint4 k0 = ldnt16(zr + C_KG), k1 = ldnt16(zr + C_KG + 8);
    *(uint4*)&RQ[(tid >> 2) * 72 + (tid & 3) * 16] = q0; *(uint4*)&RQ[(tid >> 2) * 72 + (tid & 3) * 16 + 8] = q1;
    *(uint4*)&RK[(tid >> 2) * 72 + (tid & 3) * 16] = k0; *(uint4*)&RK[(tid >> 2) * 72 + (tid & 3) * 16 + 8] = k1;
  }
  const VRegs vr = load_v(Z, t0, h, tid);
  {
    float gcf[16], gcb[16], gtf, gtb;
    gla_gates(p, t0, h, smem, part, gcf, gcb, gtf, gtb, tid);
#pragma unroll
    for (int j = 0; j < 16; ++j) {
      int tok = tq * 16 + j;
      float q = bf2f(RQ[tok * 72 + dk]) * 0.125f, k = bf2f(RK[tok * 72 + dk]);
      QdF[tok * 72 + dk] = f2bf(q * __expf(gcf[j]));
      QdB[tok * 72 + dk] = f2bf(q * __expf(gcb[j]));
      KiF[tok * 72 + dk] = f2bf(k * __expf(-gcf[j]));
      KiB[tok * 72 + dk] = f2bf(k * __expf(-gcb[j]));
    }
  }
  __syncthreads();
  store_vt(vr, Vt, tid);
  __syncthreads();
  const int ib = w & 1, dh = w >> 1;
  bf16x8 qF[4], qB[4];
#pragma unroll
  for (int ks = 0; ks < 4; ++ks) {
    qF[ks] = *(const bf16x8*)&QdF[(ib * 32 + r) * 72 + ks * 16 + hh * 8];
    qB[ks] = *(const bf16x8*)&QdB[(ib * 32 + r) * 72 + ks * 16 + hh * 8];
  }
  f32x16 comb[2];
  const int ii = ib * 32 + r;
#pragma unroll
  for (int mb = 0; mb < 2; ++mb) {
    f32x16 xf, xb;
#pragma unroll
    for (int i = 0; i < 16; ++i) { xf[i] = 0.f; xb[i] = 0.f; }
#pragma unroll
    for (int ks = 0; ks < 4; ++ks) {
      bf16x8 a = *(const bf16x8*)&KiF[(mb * 32 + r) * 72 + ks * 16 + hh * 8];
      xf = mfma32(a, qF[ks], xf);
      bf16x8 a2 = *(const bf16x8*)&KiB[(mb * 32 + r) * 72 + ks * 16 + hh * 8];
      xb = mfma32(a2, qB[ks], xb);
    }
#pragma unroll
    for (int i = 0; i < 16; ++i) {
      int jj = mb * 32 + rowmap(i, hh);
      comb[mb][i] = ((ii >= jj) ? xf[i] : 0.f) + ((ii <= jj) ? xb[i] : 0.f);
    }
  }
  f32x16 o[2];
#pragma unroll
  for (int db = 0; db < 2; ++db) {
#pragma unroll
    for (int i = 0; i < 16; ++i) o[db][i] = 0.f;
    const int dvrow = dh * 64 + db * 32 + r;
#pragma unroll
    for (int mb = 0; mb < 2; ++mb)
#pragma unroll
      for (int s = 0; s < 2; ++s) {
        u32x4 pku;
        pku.x = pack2(comb[mb][8 * s + 0], comb[mb][8 * s + 1]);
        pku.y = pack2(comb[mb][8 * s + 2], comb[mb][8 * s + 3]);
        pku.z = pack2(comb[mb][8 * s + 4], comb[mb][8 * s + 5]);
        pku.w = pack2(comb[mb][8 * s + 6], comb[mb][8 * s + 7]);
        const int kk = mb * 32 + 16 * s + 4 * hh;
        uint2 q0 = *(const uint2*)&Vt[dvrow * 72 + kk];
        uint2 q1 = *(const uint2*)&Vt[dvrow * 72 + kk + 8];
        u32x4 au; au.x = q0.x; au.y = q0.y; au.z = q1.x; au.w = q1.y;
        o[db] = mfma32(__builtin_bit_cast(bf16x8, au), __builtin_bit_cast(bf16x8, pku), o[db]);
      }
    const u16* sf = SPT + (size_t)(task * 2 + 0) * 8192 + (dh * 2 + db) * 2048 + r * 16 + hh * 8;
    const u16* sb = SPT + (size_t)(task * 2 + 1) * 8192 + (dh * 2 + db) * 2048 + r * 16 + hh * 8;
#pragma unroll
    for (int ks = 0; ks < 4; ++ks) {
      bf16x8 a = __builtin_nontemporal_load((const bf16x8*)(sf + ks * 512));
      o[db] = mfma32(a, qF[ks], o[db]);
      bf16x8 a2 = __builtin_nontemporal_load((const bf16x8*)(sb + ks * 512));
      o[db] = mfma32(a2, qB[ks], o[db]);
    }
  }
  float ss = 0.f;
#pragma unroll
  for (int db = 0; db < 2; ++db)
#pragma unroll
    for (int i = 0; i < 16; ++i) ss += o[db][i] * o[db][i];
  ss += __shfl_xor(ss, 32);
  if (hh == 0) ssq[dh * 64 + ii] = ss;
  __syncthreads();
  const float rstd = rsqrtf((ssq[ii] + ssq[64 + ii]) * (1.f / 128.f) + EPSV);
#pragma unroll
  for (int db = 0; db < 2; ++db)
#pragma unroll
    for (int g4 = 0; g4 < 4; ++g4)
      *(float4*)&Os[ii * 132 + dh * 64 + db * 32 + 8 * g4 + 4 * hh] =
          make_float4(o[db][4 * g4 + 0] * rstd, o[db][4 * g4 + 1] * rstd, o[db][4 * g4 + 2] * rstd, o[db][4 * g4 + 3] * rstd);
  __syncthreads();
#pragma unroll
  for (int i = 0; i < 4; ++i) {
    int idx = tid + 256 * i;
    int tok = idx >> 4, c8 = (idx & 15) * 8;
    float4 o0 = *(const float4*)&Os[tok * 132 + c8];
    float4 o1 = *(const float4*)&Os[tok * 132 + c8 + 4];
    float4 g0 = *(const float4*)(p.gla_norm_g + c8);
    float4 g1 = *(const float4*)(p.gla_norm_g + c8 + 4);
    uint4 zg = ldnt16(Z + (size_t)(t0 + tok) * ZW + C_ZG + h * 128 + c8);
    uint4 yo;
    yo.x = pack2(o0.x * g0.x * siluf(bflo(zg.x)), o0.y * g0.y * siluf(bfhi(zg.x)));
    yo.y = pack2(o0.z * g0.z * siluf(bflo(zg.y)), o0.w * g0.w * siluf(bfhi(zg.y)));
    yo.z = pack2(o1.x * g1.x * siluf(bflo(zg.z)), o1.y * g1.y * siluf(bfhi(zg.z)));
    yo.w = pack2(o1.z * g1.z * siluf(bflo(zg.w)), o1.w * g1.w * siluf(bfhi(zg.w)));
    *(uint4*)(Y + (size_t)(t0 + tok) * DM + 512 + h * 128 + c8) = yo;
  }
  __syncthreads();
}

__device__ void final_rows(const Params& p) {
  const int thr = opq(threadIdx.x);
  const int lane = thr & 63, w = thr >> 6;
  const u16* XN = (const u16*)(p.ws + OFF_Z);
  float4 g[4];
#pragma unroll
  for (int i = 0; i < 4; ++i) g[i] = *(const float4*)(p.final_norm_g + i * 256 + lane * 4);
  const int stride = gridDim.x * 8;
  for (int row = blockIdx.x * 8 + w; row < T_TOK; row += 2 * stride) {
    const int row1 = row + stride;
    const bool has1 = row1 < T_TOK;
    const u16* x0 = XN + (size_t)row * DM;
    const u16* x1 = XN + (size_t)(has1 ? row1 : row) * DM;
    uint2 u0[4], u1[4];
#pragma unroll
    for (int i = 0; i < 4; ++i) { u0[i] = ldnt8(x0 + i * 256 + lane * 4); u1[i] = ldnt8(x1 + i * 256 + lane * 4); }
    float4 v0[4], v1[4];
    float ss0 = 0.f, ss1 = 0.f;
#pragma unroll
    for (int i = 0; i < 4; ++i) {
      v0[i] = make_float4(bflo(u0[i].x), bfhi(u0[i].x), bflo(u0[i].y), bfhi(u0[i].y));
      v1[i] = make_float4(bflo(u1[i].x), bfhi(u1[i].x), bflo(u1[i].y), bfhi(u1[i].y));
      ss0 += v0[i].x * v0[i].x + v0[i].y * v0[i].y + v0[i].z * v0[i].z + v0[i].w * v0[i].w;
      ss1 += v1[i].x * v1[i].x + v1[i].y * v1[i].y + v1[i].z * v1[i].z + v1[i].w * v1[i].w;
    }
#pragma unroll
    for (int o = 32; o >= 1; o >>= 1) { ss0 += __shfl_xor(ss0, o); ss1 += __shfl_xor(ss1, o); }
    const float r0 = rsqrtf(ss0 * (1.f / 1024.f) + EPSV), r1 = rsqrtf(ss1 * (1.f / 1024.f) + EPSV);
    float* y0 = p.out + OUT_Y + (size_t)row * DM;
    float* y1 = p.out + OUT_Y + (size_t)row1 * DM;
#pragma unroll
    for (int i = 0; i < 4; ++i) {
      const int col = i * 256 + lane * 4;
      { f32x4 ov = {v0[i].x * r0 * g[i].x, v0[i].y * r0 * g[i].y, v0[i].z * r0 * g[i].z, v0[i].w * r0 * g[i].w}; __builtin_nontemporal_store(ov, (f32x4*)(y0 + col)); }
      if (has1) { f32x4 ov = {v1[i].x * r1 * g[i].x, v1[i].y * r1 * g[i].y, v1[i].z * r1 * g[i].z, v1[i].w * r1 * g[i].w}; __builtin_nontemporal_store(ov, (f32x4*)(y1 + col)); }
    }
  }
}

extern __shared__ __attribute__((aligned(16))) unsigned char smem_dyn[];

__global__ void __launch_bounds__(512, 2) mega(Params p) {
  unsigned char* smem_all = smem_dyn;
  cg::grid_group grid = cg::this_grid();
  if (p.ws == nullptr) grid.sync();
  if (threadIdx.x == 0) *(uint4*)(smem_all + LDS_GEMM) = make_uint4(0u, 0u, 0u, 0u);
  __syncthreads();
  const XcdBarrier xb = xcd_barrier_post((unsigned*)(p.ws + OFF_BAR), (volatile LAS unsigned*)(smem_all + LDS_GEMM));
  const int nb = gridDim.x;
  const int half = __builtin_amdgcn_readfirstlane(threadIdx.x >> 8);
#define tid (opq(threadIdx.x) & 255)
  unsigned char* smem = smem_all + half * LDS_HALF;
  for (int t = blockIdx.x * 2 + half; t < 384 + 1; t += nb * 2) {
    if (t < 384) p0_adaln(p, t, smem, tid);
    else p0_rope(p, tid);
  }
  xcd_barrier(xb);
  for (int t = blockIdx.x * 2 + half; t < 768 + 256; t += nb * 2) {
    if (t < 768) p0_transpose(p.w_in, ZW, (u16*)(p.ws + OFF_WINT), t / 48, t % 48, smem, tid);
    else { int q = t - 768; p0_transpose(p.w_out, 1024, (u16*)(p.ws + OFF_WOUTT), q >> 4, q & 15, smem, tid); }
  }
  p1_rows(p);
  xcd_barrier(xb);
  {
    pg8::Gemm g; g.A = (const u16*)(p.ws + OFF_HY); g.Bt = (const u16*)(p.ws + OFF_WINT); g.M = T_TOK; g.N = ZWP; g.K = 1024;
    pg8::StaticOrder S; S.init(T_TOK, ZWP, nb, blockIdx.x);
    EpiZ E; E.ws = p.ws; E.outp = p.out;
    pg8::gemm_phase<EpiZ, pg8::StaticOrder, false>((PG8_LAS unsigned char*)smem_all, g, S, E, nullptr);
  }
  xcd_barrier(xb);
  for (int t = blockIdx.x * 2 + half; t < 1536 + 832; t += nb * 2) {
    if (t < 1536) gla_ds_task(p, t, smem, tid);
    else vt_task(p, t - 1536, smem, tid);
  }
  xcd_barrier(xb);
  {
    const bool scan_first = (blockIdx.x >> 3) & 1;
    for (int sp = 0; sp < 2; ++sp) {
      if ((sp == 0) == scan_first) {
        for (int t = blockIdx.x * 2 + half; t < 512; t += nb * 2) gla_scan_task(p, t, tid);
        for (int q = blockIdx.x * 2 + half; q < 1024; q += nb * 2) gla_scan_prompt4(p, q, tid);
      } else {
        for (int t = blockIdx.x * 2 + half; t < 1536; t += nb * 2) {
          int item = t;
          if (t < 1024) {
            const int k = t >> 9, wg = (t & 511) >> 1, hf = t & 1;
            const int x = wg & 7, j = wg >> 3;
            item = ((x >> 1) << 8) | ((x & 1) << 7) | (j << 2) | (2 * k + hf);
          }
          attn_item(p, item, smem, tid);
        }
      }
    }
  }
  xcd_barrier(xb);
  for (int t = blockIdx.x * 2 + half; t < 1536; t += nb * 2) gla_out_task(p, t, smem, tid);
  xcd_barrier(xb);
  {
    pg8::Gemm g; g.A = (const u16*)(p.ws + OFF_HY); g.Bt = (const u16*)(p.ws + OFF_WOUTT); g.M = T_TOK; g.N = 1024; g.K = 1024;
    pg8::StaticOrder S; S.init(T_TOK, 1024, nb, blockIdx.x);
    EpiOut E; E.ws = p.ws; E.outp = p.out; E.xp = p.xp; E.xs = p.xs;
    pg8::gemm_phase<EpiOut, pg8::StaticOrder, false>((PG8_LAS unsigned char*)smem_all, g, S, E, nullptr);
  }
  xcd_barrier(xb);
  final_rows(p);
#undef tid
}

extern "C" void kernel_launch(void* const* d_in, const int* in_sizes, int n_in, void* d_out, int out_size,
                              void* d_ws, size_t ws_size, hipStream_t stream) {
  static int grid_blocks = 0;
  if (!grid_blocks) {
    int dev = 0, cus = 0, per_cu = 0;
    (void)hipGetDevice(&dev);
    (void)hipDeviceGetAttribute(&cus, hipDeviceAttributeMultiprocessorCount, dev);
    (void)hipFuncSetAttribute((const void*)mega, hipFuncAttributeMaxDynamicSharedMemorySize, LDS_TOTAL);
    (void)hipOccupancyMaxActiveBlocksPerMultiprocessor(&per_cu, mega, 512, LDS_TOTAL);
    if (per_cu < 1) per_cu = 1;
    grid_blocks = cus;
  }
  Params p{};
  const float** pp = (const float**)&p;
  for (int i = 0; i < 19; ++i) pp[i] = (const float*)d_in[i];
  p.out = (float*)d_out;
  p.ws = (unsigned char*)d_ws;
  (void)hipMemsetAsync((char*)d_ws + OFF_BAR, 0, XCD_BAR_WORDS * 4, stream);
  void* args[] = {&p};
  hipError_t e = hipLaunchCooperativeKernel((void*)mega, dim3(grid_blocks), dim3(512), args, LDS_TOTAL, stream);
  if (e != hipSuccess) fprintf(stderr, "cooperative launch failed: %s (grid %d)\n", hipGetErrorString(e), grid_blocks);
}
```
